# Optimizing an MI355X kernel written in HIP

```python
import math
import jax, jax.numpy as jnp
from jax import lax
import numpy as np

D_MODEL = 2048
BATCH = 16
SEQ = 2048
DEPTH = 4

N_A = DEPTH // 2
N_B = DEPTH - N_A
A_QK_DIM = 128
A_V_DIM = 2 * A_QK_DIM
A_HEADS = D_MODEL // A_V_DIM
A_WIDTH = A_HEADS * A_V_DIM
B_HEAD_DIM = 128
B_HEADS = D_MODEL // B_HEAD_DIM
B_WIDTH = B_HEADS * B_HEAD_DIM
BLOCK = 128
NEG = -1e30
EPS = 1e-5
DN_ALPHA = (2.0 * DEPTH) ** 0.25
DN_BETA = (8.0 * DEPTH) ** -0.25

kernel_name = "yoco_diffattn_fox_hybrid"


def layer_norm(x, g, b):
    xf = x.astype(jnp.float32)
    mu = jnp.mean(xf, axis=-1, keepdims=True)
    var = jnp.mean(jnp.square(xf - mu), axis=-1, keepdims=True)
    y = (xf - mu) * lax.rsqrt(var + EPS)
    return (y * g.astype(jnp.float32) + b.astype(jnp.float32)).astype(x.dtype)


def rms_norm(x, g):
    xf = x.astype(jnp.float32)
    y = xf * lax.rsqrt(jnp.mean(jnp.square(xf), axis=-1, keepdims=True) + EPS)
    return (y * g.astype(jnp.float32)).astype(x.dtype)


def to_blocks(a):
    b, s = a.shape[:2]
    a = a.reshape((b, s // BLOCK, BLOCK) + a.shape[2:])
    return jnp.moveaxis(a, 1, 0)


def from_blocks(a):
    a = jnp.moveaxis(a, 0, 1)
    return a.reshape((a.shape[0], a.shape[1] * a.shape[2]) + a.shape[3:])


def alibi_slopes(n_heads):
    return jnp.asarray([2.0 ** (-8.0 * (h + 1) / n_heads) for h in range(n_heads)], dtype=jnp.float32)


def diff_attention(h, w_in, w_out, lq1, lk1, lq2, lk2, subln_g, layer_idx):
    B, S, _ = h.shape
    proj = h @ w_in
    q, k, v, g = jnp.split(proj, 4, axis=-1)
    q = q.reshape(B, S, A_HEADS, 2, A_QK_DIM) * (A_QK_DIM ** -0.5)
    k = k.reshape(B, S, A_HEADS, 2, A_QK_DIM)
    v = v.reshape(B, S, A_HEADS, A_V_DIM)
    lam_init = 0.8 - 0.6 * math.exp(-0.3 * layer_idx)
    f32 = jnp.float32
    lam = (jnp.exp(jnp.sum(lq1.astype(f32) * lk1.astype(f32)))
           - jnp.exp(jnp.sum(lq2.astype(f32) * lk2.astype(f32))) + lam_init)
    slopes = alibi_slopes(A_HEADS)
    s_pos = jnp.arange(S)

    def block(args):
        qb, i = args
        t_pos = i * BLOCK + jnp.arange(BLOCK)
        dist = (t_pos[:, None] - s_pos[None, :]).astype(f32)
        bias = -slopes[:, None, None] * dist
        sc = jnp.einsum('bqhcd,bkhcd->bhcqk', qb, k).astype(f32) + bias[None, :, None]
        sc = jnp.where(dist >= 0, sc, NEG)
        p = jax.nn.softmax(sc, axis=-1)
        a = p[:, :, 0] - lam * p[:, :, 1]
        return jnp.einsum('bhqk,bkhe->bqhe', a.astype(v.dtype), v)

    o = from_blocks(lax.map(block, (to_blocks(q), jnp.arange(S // BLOCK))))
    o = rms_norm(o, subln_g) * (1.0 - lam_init)
    o = o.reshape(B, S, A_WIDTH) * jax.nn.silu(g)
    return o @ w_out


def shared_kv(x, c_act, w_mod_kv, b_mod_kv, w_kv, b_f):
    B, S, _ = x.shape
    mod = c_act @ w_mod_kv + b_mod_kv
    shift, scale = jnp.split(mod, 2, axis=-1)
    hk = x * (1.0 + scale[:, None]) + shift[:, None]
    kvf = hk @ w_kv
    k, v, zf = jnp.split(kvf, [B_WIDTH, 2 * B_WIDTH], axis=-1)
    k = k.reshape(B, S, B_HEADS, B_HEAD_DIM)
    v = v.reshape(B, S, B_HEADS, B_HEAD_DIM)
    log_f = jax.nn.log_sigmoid(zf.astype(jnp.float32) + b_f.astype(jnp.float32))
    F = jnp.cumsum(log_f, axis=1)
    return k, v, F


def forgetting_attention(h, w_q, w_out, k, v, F):
    B, S, _ = h.shape
    f32 = jnp.float32
    proj = h @ w_q
    q, g = jnp.split(proj, 2, axis=-1)
    q = q.reshape(B, S, B_HEADS, B_HEAD_DIM) * (B_HEAD_DIM ** -0.5)
    Fk = jnp.moveaxis(F, 1, 2)
    s_pos = jnp.arange(S)

    def block(args):
        qb, Fq, i = args
        t_pos = i * BLOCK + jnp.arange(BLOCK)
        causal = t_pos[:, None] >= s_pos[None, :]
        decay = jnp.moveaxis(Fq, 1, 2)[..., None] - Fk[:, :, None, :]
        sc = jnp.einsum('bqhd,bkhd->bhqk', qb, k).astype(f32) + decay
        sc = jnp.where(causal, sc, NEG)
        p = jax.nn.softmax(sc, axis=-1)
        return jnp.einsum('bhqk,bkhd->bqhd', p.astype(v.dtype), v)

    o = from_blocks(lax.map(block, (to_blocks(q), to_blocks(F), jnp.arange(S // BLOCK))))
    o = o.reshape(B, S, B_WIDTH) * jax.nn.silu(g)
    return o @ w_out


def setup_inputs(seed: int = 0) -> dict:
    key = jax.random.key(seed)
    ks = jax.random.split(key, 20)
    nrm = jax.random.normal
    D = D_MODEL
    x = nrm(ks[0], (BATCH, SEQ, D), jnp.float32)
    c = nrm(ks[1], (BATCH, D), jnp.float32)
    w_mod = nrm(ks[2], (DEPTH, D, 3 * D), jnp.float32) * D ** -0.5
    b_mod = nrm(ks[3], (DEPTH, 3 * D), jnp.float32) * 0.02
    ln_g = 1.0 + 0.02 * nrm(ks[4], (DEPTH, D), jnp.float32)
    ln_b = 0.02 * nrm(ks[5], (DEPTH, D), jnp.float32)
    a_w_in = nrm(ks[6], (N_A, D, 4 * A_WIDTH), jnp.float32) * D ** -0.5
    a_w_out = nrm(ks[7], (N_A, A_WIDTH, D), jnp.float32) * (A_WIDTH ** -0.5 * DN_BETA)
    a_lam_q1 = 0.1 * nrm(ks[8], (N_A, A_QK_DIM), jnp.float32)
    a_lam_k1 = 0.1 * nrm(ks[9], (N_A, A_QK_DIM), jnp.float32)
    a_lam_q2 = 0.1 * nrm(ks[10], (N_A, A_QK_DIM), jnp.float32)
    a_lam_k2 = 0.1 * nrm(ks[11], (N_A, A_QK_DIM), jnp.float32)
    a_subln_g = 1.0 + 0.02 * nrm(ks[12], (N_A, A_V_DIM), jnp.float32)
    kv_w_mod = nrm(ks[13], (D, 2 * D), jnp.float32) * D ** -0.5
    kv_b_mod = nrm(ks[14], (2 * D,), jnp.float32) * 0.02
    kv_w = nrm(ks[15], (D, 2 * B_WIDTH + B_HEADS), jnp.float32) * D ** -0.5
    kv_b_f = jax.random.uniform(ks[16], (B_HEADS,), jnp.float32, minval=1.0, maxval=6.0)
    b_w_in = nrm(ks[17], (N_B, D, 2 * B_WIDTH), jnp.float32) * D ** -0.5
    b_w_out = nrm(ks[18], (N_B, B_WIDTH, D), jnp.float32) * (B_WIDTH ** -0.5 * DN_BETA)
    return {"x": x, "c": c, "w_mod": w_mod, "b_mod": b_mod, "ln_g": ln_g, "ln_b": ln_b,
            "a_w_in": a_w_in, "a_w_out": a_w_out, "a_lam_q1": a_lam_q1, "a_lam_k1": a_lam_k1,
            "a_lam_q2": a_lam_q2, "a_lam_k2": a_lam_k2, "a_subln_g": a_subln_g,
            "kv_w_mod": kv_w_mod, "kv_b_mod": kv_b_mod, "kv_w": kv_w, "kv_b_f": kv_b_f,
            "b_w_in": b_w_in, "b_w_out": b_w_out}


def reference(x, c, w_mod, b_mod, ln_g, ln_b, a_w_in, a_w_out, a_lam_q1, a_lam_k1,
              a_lam_q2, a_lam_k2, a_subln_g, kv_w_mod, kv_b_mod, kv_w, kv_b_f,
              b_w_in, b_w_out):
    c_act = jax.nn.silu(c)
    kv = None
    for l in range(DEPTH):
        mod = c_act @ w_mod[l] + b_mod[l]
        shift, scale, gate = jnp.split(mod, 3, axis=-1)
        h = x * (1.0 + scale[:, None]) + shift[:, None]
        if l < N_A:
            y = diff_attention(h, a_w_in[l], a_w_out[l], a_lam_q1[l], a_lam_k1[l],
                               a_lam_q2[l], a_lam_k2[l], a_subln_g[l], l)
        else:
            if kv is None:
                kv = shared_kv(x, c_act, kv_w_mod, kv_b_mod, kv_w, kv_b_f)
            k_sh, v_sh, F_sh = kv
            y = forgetting_attention(h, b_w_in[l - N_A], b_w_out[l - N_A], k_sh, v_sh, F_sh)
        x = layer_norm(DN_ALPHA * x + gate[:, None] * y, ln_g[l], ln_b[l])
    return x
```

```cpp
#include <hip/hip_runtime.h>
#include <hip/hip_cooperative_groups.h>
#include <cstdio>
namespace cg = cooperative_groups;

#ifndef MK_MULTI
#define MK_MULTI 0
#endif

typedef unsigned short u16;
using bf16x8 = __attribute__((ext_vector_type(8))) short;
using s16x4  = __attribute__((ext_vector_type(4))) short;
using f32x4  = __attribute__((ext_vector_type(4))) float;
using f32x16 = __attribute__((ext_vector_type(16))) float;
using i32x4  = __attribute__((ext_vector_type(4))) int;
using u32x2  = __attribute__((ext_vector_type(2))) unsigned;
using u32x4  = __attribute__((ext_vector_type(4))) unsigned;
typedef __attribute__((ext_vector_type(2))) __bf16 bf2_t;
typedef __attribute__((ext_vector_type(2))) float f2_t;
#define LAS __attribute__((address_space(3)))
#define DI __device__ __forceinline__
#ifndef REP_A
#define REP_A 1
#endif
#ifndef REP_B
#define REP_B 1
#endif
#ifndef REP_G
#define REP_G 1
#endif

constexpr int D = 2048, NBATCH = 16, S = 2048, M = NBATCH * S;
constexpr int MODW = 28672;
constexpr int KSPLIT = 16;
constexpr float LOG2E = 1.4426950408889634f;
constexpr float DN_ALPHA = 1.681792830507429f;
constexpr float EPS = 1e-5f;

constexpr size_t WS_WT_AIN  = 0;
constexpr size_t WS_WT_AOUT = WS_WT_AIN  + (size_t)2 * 8192 * 2048 * 2;
constexpr size_t WS_WT_KV   = WS_WT_AOUT + (size_t)2 * 2048 * 2048 * 2;
constexpr size_t WS_WT_BIN  = WS_WT_KV   + (size_t)4352 * 2048 * 2;
constexpr size_t WS_WT_BOUT = WS_WT_BIN  + (size_t)2 * 4096 * 2048 * 2;
constexpr size_t WS_PART    = WS_WT_BOUT + (size_t)2 * 2048 * 2048 * 2;
constexpr size_t WS_MODF    = WS_PART    + (size_t)KSPLIT * 16 * MODW * 4;
constexpr size_t WS_ZF      = WS_MODF    + (size_t)16 * MODW * 4;
constexpr size_t WS_FCUM    = WS_ZF      + (size_t)M * 16 * 4;
constexpr size_t WS_H       = WS_FCUM    + (size_t)M * 16 * 4;
constexpr size_t WS_PROJ    = WS_H       + (size_t)M * 2048 * 2;
constexpr size_t WS_BAR     = WS_PROJ    + (size_t)M * 8192 * 2;
constexpr size_t WS_STATS   = WS_BAR     + 4096;
constexpr size_t WS_END     = WS_STATS   + (size_t)128 * 8 * 256 * 8;

constexpr int LDS_BYTES = 2 * 64 * (528 + 576) + 2 * 2 * 64 * 4;
constexpr int NPHASE = 16;

struct Params {
  const float *x, *c, *w_mod, *b_mod, *ln_g, *ln_b, *a_w_in, *a_w_out, *lq1, *lk1, *lq2, *lk2, *subln,
              *kv_w_mod, *kv_b_mod, *kv_w, *kv_b_f, *b_w_in, *b_w_out;
  float* out; char* ws; int ph_lo, ph_hi;
};

extern __shared__ __attribute__((aligned(1024))) char shm[];

DI unsigned pack2(float a, float b) { f2_t v = {a, b}; bf2_t r = __builtin_convertvector(v, bf2_t); return __builtin_bit_cast(unsigned, r); }
DI float bf_lo(unsigned u) { return __uint_as_float(u << 16); }
DI float bf_hi(unsigned u) { return __uint_as_float(u & 0xffff0000u); }
DI float silu_f(float x) { return x / (1.f + __expf(-x)); }
DI int tid_opq() { int t = threadIdx.x; asm volatile("" : "+v"(t)); return t; }
DI int bid_opq() { int b = blockIdx.x; asm volatile("" : "+s"(b)); return b; }
DI float xor32_max(float x) {
  auto r = __builtin_amdgcn_permlane32_swap(__float_as_uint(x), __float_as_uint(x), false, false);
  return fmaxf(__uint_as_float(r[0]), __uint_as_float(r[1]));
}
DI float wave_sum(float v) {
#pragma unroll
  for (int o = 32; o >= 1; o >>= 1) v += __shfl_xor(v, o);
  return v;
}

DI void convert_tile(const float* __restrict__ W, int N, u16* __restrict__ Wt, int tk, int tn) {
  float* tile = (float*)shm;
  const int tid = tid_opq(), k0 = tk * 64, n0 = tn * 64;
#pragma unroll
  for (int i = 0; i < 2; ++i) {
    int kk = (tid >> 4) + 32 * i, c4 = (tid & 15) * 4, n = n0 + c4;
    f32x4 v = {0.f, 0.f, 0.f, 0.f};
    if (n < N) v = *(const f32x4*)(W + (size_t)(k0 + kk) * N + n);
    tile[kk * 65 + c4 + 0] = v[0]; tile[kk * 65 + c4 + 1] = v[1]; tile[kk * 65 + c4 + 2] = v[2]; tile[kk * 65 + c4 + 3] = v[3];
  }
  __syncthreads();
  {
    int n = tid >> 3, ks = tid & 7;
    float f[8];
#pragma unroll
    for (int j = 0; j < 8; ++j) f[j] = tile[(ks * 8 + j) * 65 + n];
    u32x4 o = {pack2(f[0], f[1]), pack2(f[2], f[3]), pack2(f[4], f[5]), pack2(f[6], f[7])};
    *(u32x4*)(Wt + (size_t)(n0 + n) * 2048 + k0 + ks * 8) = o;
  }
  __syncthreads();
}

DI void mod_task(const Params& p, int task) {
  float* cact = (float*)shm;
  float* part = (float*)(p.ws + WS_PART);
  const int tid = tid_opq();
  const int ks = task / 14, cgp = task % 14, k0 = ks * 128;
  const int c = (cgp * 512 + tid) * 4;
  const float* W; int N, lc;
  if (c < 24576) { int set = c / 6144; W = p.w_mod + (size_t)set * 2048 * 6144; N = 6144; lc = c - set * 6144; }
  else { W = p.kv_w_mod; N = 4096; lc = c - 24576; }
  for (int idx = tid; idx < 128 * 16; idx += 512) {
    int kk = idx & 127, b = idx >> 7;
    float v = p.c[b * 2048 + k0 + kk];
    cact[kk * 16 + b] = silu_f(v);
  }
  __syncthreads();
  f32x4 acc[16];
#pragma unroll
  for (int b = 0; b < 16; ++b) acc[b] = (f32x4){0.f, 0.f, 0.f, 0.f};
  const float* wp = W + (size_t)k0 * N + lc;
#pragma unroll 4
  for (int kk = 0; kk < 128; ++kk) {
    f32x4 w = *(const f32x4*)(wp + (size_t)kk * N);
#pragma unroll
    for (int q = 0; q < 4; ++q) {
      f32x4 cv = *(const f32x4*)(cact + kk * 16 + q * 4);
#pragma unroll
      for (int e = 0; e < 4; ++e) acc[q * 4 + e] += cv[e] * w;
    }
  }
#pragma unroll
  for (int b = 0; b < 16; ++b) *(f32x4*)(part + (size_t)(ks * 16 + b) * MODW + c) = acc[b];
  __syncthreads();
}

DI void phase0(const Params& p) {
  constexpr int NMOD = 14 * KSPLIT;
  constexpr int NCONV = 8192 + 2048 + 2080 + 4096 + 2048;
  for (int u = bid_opq(); u < NMOD + NCONV; u += gridDim.x) {
    if (u < NMOD) { mod_task(p, u); continue; }
    int t = u - NMOD;
    const float* W; u16* Wt; int N, ntn;
    if (t < 8192) { int l = t >> 12; t &= 4095; W = p.a_w_in + (size_t)l * 2048 * 8192; Wt = (u16*)(p.ws + WS_WT_AIN) + (size_t)l * 8192 * 2048; N = 8192; ntn = 128; }
    else if (t < 8192 + 2048) { t -= 8192; int l = t >> 10; t &= 1023; W = p.a_w_out + (size_t)l * 2048 * 2048; Wt = (u16*)(p.ws + WS_WT_AOUT) + (size_t)l * 2048 * 2048; N = 2048; ntn = 32; }
    else if (t < 8192 + 2048 + 2080) { t -= 8192 + 2048; W = p.kv_w; Wt = (u16*)(p.ws + WS_WT_KV); N = 4112; ntn = 65; }
    else if (t < 8192 + 2048 + 2080 + 4096) { t -= 8192 + 2048 + 2080; int l = t >> 11; t &= 2047; W = p.b_w_in + (size_t)l * 2048 * 4096; Wt = (u16*)(p.ws + WS_WT_BIN) + (size_t)l * 4096 * 2048; N = 4096; ntn = 64; }
    else { t -= 8192 + 2048 + 2080 + 4096; int l = t >> 10; t &= 1023; W = p.b_w_out + (size_t)l * 2048 * 2048; Wt = (u16*)(p.ws + WS_WT_BOUT) + (size_t)l * 2048 * 2048; N = 2048; ntn = 32; }
    convert_tile(W, N, Wt, t / ntn, t % ntn);
  }
}

DI void phase_modfin(const Params& p) {
  const float* part = (const float*)(p.ws + WS_PART);
  float* modf = (float*)(p.ws + WS_MODF);
  for (int idx = bid_opq() * 512 + tid_opq(); idx < 16 * (MODW / 4); idx += gridDim.x * 512) {
    int b = idx / (MODW / 4), c = (idx % (MODW / 4)) * 4;
    f32x4 s = (c < 24576) ? *(const f32x4*)(p.b_mod + c) : *(const f32x4*)(p.kv_b_mod + (c - 24576));
#pragma unroll
    for (int ks = 0; ks < KSPLIT; ++ks) s += *(const f32x4*)(part + (size_t)(ks * 16 + b) * MODW + c);
    *(f32x4*)(modf + (size_t)b * MODW + c) = s;
  }
}

DI void phase_modulate0(const Params& p) {
  const float* modf = (const float*)(p.ws + WS_MODF);
  u16* hb = (u16*)(p.ws + WS_H);
  const int tid_ = tid_opq(), lane = tid_ & 63, wave = tid_ >> 6;
  for (int row = bid_opq() * 8 + wave; row < M; row += gridDim.x * 8) {
    const int b = row >> 11;
#pragma unroll
    for (int i = 0; i < 8; ++i) {
      int col = (i * 64 + lane) * 4;
      f32x4 v = *(const f32x4*)(p.x + (size_t)row * D + col);
      f32x4 sh = *(const f32x4*)(modf + (size_t)b * MODW + col);
      f32x4 sc = *(const f32x4*)(modf + (size_t)b * MODW + 2048 + col);
      f32x4 h = v * (1.f + sc) + sh;
      u32x2 o = {pack2(h[0], h[1]), pack2(h[2], h[3])};
      *(u32x2*)(hb + (size_t)row * D + col) = o;
    }
  }
}

DI void phase_ln(float* xio, const float* __restrict__ lng, const float* __restrict__ lnb,
                 const float* modn, u16* hout, const float* modkv, u16* hkout) {
  const int tid_ = tid_opq(), lane = tid_ & 63, wave = tid_ >> 6;
  for (int row0 = (bid_opq() * 8 + wave) * 2; row0 < M; row0 += gridDim.x * 16) {
    const int b = row0 >> 11;
    f32x4 v[2][8];
    float s[2] = {0.f, 0.f};
#pragma unroll
    for (int rr = 0; rr < 2; ++rr)
#pragma unroll
      for (int i = 0; i < 8; ++i) v[rr][i] = *(const f32x4*)(xio + (size_t)(row0 + rr) * D + (i * 64 + lane) * 4);
#pragma unroll
    for (int rr = 0; rr < 2; ++rr)
#pragma unroll
      for (int i = 0; i < 8; ++i) s[rr] += v[rr][i][0] + v[rr][i][1] + v[rr][i][2] + v[rr][i][3];
    float mu[2], rstd[2];
#pragma unroll
    for (int rr = 0; rr < 2; ++rr) {
      mu[rr] = wave_sum(s[rr]) * (1.f / 2048.f);
      float q = 0.f;
#pragma unroll
      for (int i = 0; i < 8; ++i) { f32x4 d = v[rr][i] - mu[rr]; q += d[0] * d[0] + d[1] * d[1] + d[2] * d[2] + d[3] * d[3]; }
      rstd[rr] = rsqrtf(wave_sum(q) * (1.f / 2048.f) + EPS);
    }
#pragma unroll
    for (int i = 0; i < 8; ++i) {
      const int col = (i * 64 + lane) * 4;
      const f32x4 g = *(const f32x4*)(lng + col), bb = *(const f32x4*)(lnb + col);
      f32x4 sh = {0.f, 0.f, 0.f, 0.f}, sc = sh, shk = sh, sck = sh;
      if (modn) { sh = *(const f32x4*)(modn + (size_t)b * MODW + col); sc = *(const f32x4*)(modn + (size_t)b * MODW + 2048 + col); }
      if (modkv) { shk = *(const f32x4*)(modkv + (size_t)b * MODW + col); sck = *(const f32x4*)(modkv + (size_t)b * MODW + 2048 + col); }
#pragma unroll
      for (int rr = 0; rr < 2; ++rr) {
        const size_t off = (size_t)(row0 + rr) * D + col;
        f32x4 y = (v[rr][i] - mu[rr]) * rstd[rr] * g + bb;
        *(f32x4*)(xio + off) = y;
        if (modn) { f32x4 h = y * (1.f + sc) + sh; u32x2 o = {pack2(h[0], h[1]), pack2(h[2], h[3])}; *(u32x2*)(hout + off) = o; }
        if (modkv) { f32x4 h = y * (1.f + sck) + shk; u32x2 o = {pack2(h[0], h[1]), pack2(h[2], h[3])}; *(u32x2*)(hkout + off) = o; }
      }
    }
  }
}

DI void phase_fscan(const Params& p) {
  const float* zf = (const float*)(p.ws + WS_ZF);
  float* F = (float*)(p.ws + WS_FCUM);
  const int tid_ = tid_opq(), lane = tid_ & 63, wave = tid_ >> 6;
  for (int seq = bid_opq() * 8 + wave; seq < 256; seq += gridDim.x * 8) {
    const int b = seq >> 4, h = seq & 15;
    const float bf = p.kv_b_f[h];
    float run = 0.f, loc[32];
#pragma unroll
    for (int j = 0; j < 32; ++j) {
      float y = zf[((size_t)b * S + lane * 32 + j) * 16 + h] + bf;
      float ls = fminf(y, 0.f) - log1pf(__expf(-fabsf(y)));
      run += ls; loc[j] = run;
    }
    float incl = run;
#pragma unroll
    for (int o = 1; o < 64; o <<= 1) { float t = __shfl_up(incl, o); if (lane >= o) incl += t; }
    const float excl = incl - run;
    float* dst = F + (size_t)seq * S + lane * 32;
#pragma unroll
    for (int j = 0; j < 32; j += 4) { f32x4 o = {loc[j] + excl, loc[j + 1] + excl, loc[j + 2] + excl, loc[j + 3] + excl}; *(f32x4*)(dst + j) = o; }
  }
}

template <int KS> DI int lds_byte(int r, int c) {
  int st = (r >> 4) * KS + (c >> 5), ob = (r & 15) * 64 + (c & 31) * 2;
  return st * 1024 + (ob ^ (((ob >> 9) & 1) << 5));
}
template <int KS> DI void stage_rc(int b, int& R, int& C) {
  int st = b >> 10, sb = b & 1023, swz = sb ^ (((sb >> 9) & 1) << 5);
  R = (st / KS) * 16 + swz / 64;
  C = (st % KS) * 32 + (swz % 64) / 2;
}
#define WAIT_V(n) asm volatile("s_waitcnt vmcnt(%0)" ::"n"(n) : "memory")

struct EpiStore { u16* out; int ld; int ncut; float* zf; };
struct EpiResid { const float* xin; float* out; const float* gate;
                  const float* lng; const float* lnb; const float* modn; u16* hout; const float* modkv; u16* hkout;
                  float* stats; unsigned* cnt; unsigned target; };

DI void epi_store(const EpiStore& E, int row, int col, f32x4 v) {
  if (col < E.ncut) { u32x2 o = {pack2(v[0], v[1]), pack2(v[2], v[3])}; *(u32x2*)(E.out + (size_t)row * E.ld + col) = o; }
  else if (col < E.ncut + 16) { *(f32x4*)(E.zf + (size_t)row * 16 + (col - E.ncut)) = v; }
}
DI void gemm_epilogue(const EpiStore& E, f32x4 (&acc)[8][4], int brow, int bcol, int, int, int, int, int) {
  const int tid = tid_opq(), wid = tid >> 6, lane = tid & 63, wr = wid >> 2, wc = wid & 3, fr = lane & 15, fq = lane >> 4;
  if (bcol + 256 > E.ncut) {
#pragma unroll
    for (int m = 0; m < 8; ++m)
#pragma unroll
      for (int n = 0; n < 4; ++n) epi_store(E, brow + wr * 128 + m * 16 + fr, bcol + wc * 64 + n * 16 + fq * 4, acc[m][n]);
  } else {
    constexpr int EP = 528;
    LAS char* eb = (LAS char*)shm + 65536;
    LAS char* wp = eb + (wr * 64 + fr) * EP + (wc * 64 + fq * 4) * 2;
    LAS char* rp = eb + (tid >> 5) * EP + (tid & 31) * 16;
    u16* gp = E.out + (size_t)(brow + (tid >> 5)) * E.ld + bcol + (tid & 31) * 8;
    __syncthreads();
#pragma unroll
    for (int half = 0; half < 2; ++half) {
#pragma unroll
      for (int mm = 0; mm < 4; ++mm)
#pragma unroll
        for (int n = 0; n < 4; ++n) {
          const f32x4 v = acc[half * 4 + mm][n];
          u32x2 o = {pack2(v[0], v[1]), pack2(v[2], v[3])};
          *(LAS u32x2*)(wp + mm * 16 * EP + n * 32) = o;
        }
      __syncthreads();
#pragma unroll
      for (int i = 0; i < 8; ++i) {
        const u32x4 v = *(LAS u32x4*)(rp + i * 16 * EP);
        __builtin_nontemporal_store(v, (u32x4*)(gp + (size_t)((i >> 2) * 128 + (i & 3) * 16 + half * 64) * E.ld));
        if (i == 3) asm volatile("" ::: "memory");
      }
      __syncthreads();
    }
  }
}

DI void gemm_epilogue(const EpiResid& E, f32x4 (&acc)[8][4], int brow, int bcol, int, int, int, int, int) {
  const int tid = tid_opq(), wid = tid >> 6, lane = tid & 63, wr = wid >> 2, wc = wid & 3, fr = lane & 15, fq = lane >> 4;
  LAS float* st_lds = (LAS float*)((LAS char*)shm + 131072);
  LAS float* mr_lds = (LAS float*)((LAS char*)shm + 131072 + 8192);
  const int b = brow >> 11, pm = brow >> 8, pn = bcol >> 8;
  const int col0 = bcol + wc * 64 + fq * 4;
  const float* gtp = E.gate + (size_t)b * MODW + col0;
  f32x4 xa[4], xb[4];
#pragma unroll
  for (int n = 0; n < 4; ++n) xa[n] = __builtin_nontemporal_load((const f32x4*)(E.xin + (size_t)(brow + wr * 128 + fr) * D + col0 + n * 16));
#pragma unroll
  for (int m = 0; m < 8; ++m) {
    asm volatile("" ::: "memory");
    if (m + 1 < 8) {
#pragma unroll
      for (int n = 0; n < 4; ++n) {
        const f32x4 t = __builtin_nontemporal_load((const f32x4*)(E.xin + (size_t)(brow + wr * 128 + (m + 1) * 16 + fr) * D + col0 + n * 16));
        if (m & 1) xa[n] = t; else xb[n] = t;
      }
    }
    asm volatile("" ::: "memory");
    float s1 = 0.f, s2 = 0.f;
#pragma unroll
    for (int n = 0; n < 4; ++n) {
      const f32x4 gtv = *(const f32x4*)(gtp + n * 16);
      f32x4 v = DN_ALPHA * ((m & 1) ? xb[n] : xa[n]) + gtv * acc[m][n];
      acc[m][n] = v;
      s1 += (v[0] + v[1]) + (v[2] + v[3]);
      s2 = __builtin_fmaf(v[0], v[0], s2); s2 = __builtin_fmaf(v[1], v[1], s2); s2 = __builtin_fmaf(v[2], v[2], s2); s2 = __builtin_fmaf(v[3], v[3], s2);
    }
    s1 += __shfl_xor(s1, 16); s2 += __shfl_xor(s2, 16);
    s1 += __shfl_xor(s1, 32); s2 += __shfl_xor(s2, 32);
    if (fq == 0) { const int lr = wr * 128 + m * 16 + fr; st_lds[(wc * 256 + lr) * 2] = s1; st_lds[(wc * 256 + lr) * 2 + 1] = s2; }
  }
  __syncthreads();
  if (tid < 256) {
    float s1 = 0.f, s2 = 0.f;
#pragma unroll
    for (int w = 0; w < 4; ++w) { s1 += st_lds[(w * 256 + tid) * 2]; s2 += st_lds[(w * 256 + tid) * 2 + 1]; }
    float* dst = E.stats + ((size_t)(pm * 8 + pn) * 256 + tid) * 2;
    __hip_atomic_store(dst, s1, __ATOMIC_RELAXED, __HIP_MEMORY_SCOPE_AGENT);
    __hip_atomic_store(dst + 1, s2, __ATOMIC_RELAXED, __HIP_MEMORY_SCOPE_AGENT);
  }
  asm volatile("s_waitcnt vmcnt(0) lgkmcnt(0)" ::: "memory");
  __syncthreads();
  if (tid == 0) {
    __hip_atomic_fetch_add(E.cnt + pm, 1u, __ATOMIC_RELAXED, __HIP_MEMORY_SCOPE_AGENT);
    unsigned spins = 0;
    while (__hip_atomic_load(E.cnt + pm, __ATOMIC_RELAXED, __HIP_MEMORY_SCOPE_AGENT) < E.target && ++spins < (1u << 24)) __builtin_amdgcn_s_sleep(1);
  }
  __syncthreads();
  if (tid < 256) {
    float s1 = 0.f, s2 = 0.f;
#pragma unroll
    for (int j = 0; j < 8; ++j) {
      const float* src = E.stats + ((size_t)(pm * 8 + j) * 256 + tid) * 2;
      s1 += __hip_atomic_load(src, __ATOMIC_RELAXED, __HIP_MEMORY_SCOPE_AGENT); s2 += __hip_atomic_load(src + 1, __ATOMIC_RELAXED, __HIP_MEMORY_SCOPE_AGENT);
    }
    const float mu = s1 * (1.f / 2048.f);
    const float var = fmaxf(s2 * (1.f / 2048.f) - mu * mu, 0.f);
    mr_lds[tid * 2] = mu; mr_lds[tid * 2 + 1] = rsqrtf(var + EPS);
  }
  __syncthreads();
#pragma unroll
  for (int n = 0; n < 4; ++n) {
    asm volatile("" ::: "memory");
    const int col = col0 + n * 16;
    const f32x4 g = *(const f32x4*)(E.lng + col), bb = *(const f32x4*)(E.lnb + col);
    f32x4 sh = {0.f, 0.f, 0.f, 0.f}, sc = sh, shk = sh, sck = sh;
    if (E.modn) { sh = *(const f32x4*)(E.modn + (size_t)b * MODW + col); sc = *(const f32x4*)(E.modn + (size_t)b * MODW + 2048 + col); }
    if (E.modkv) { shk = *(const f32x4*)(E.modkv + (size_t)b * MODW + col); sck = *(const f32x4*)(E.modkv + (size_t)b * MODW + 2048 + col); }
#pragma unroll
    for (int m = 0; m < 8; ++m) {
      const int lr = wr * 128 + m * 16 + fr;
      const float mu = mr_lds[lr * 2], rstd = mr_lds[lr * 2 + 1];
      const size_t off = (size_t)(brow + lr) * D + col;
      f32x4 y = (acc[m][n] - mu) * rstd * g + bb;
      __builtin_nontemporal_store(y, (f32x4*)(E.out + off));
      if (E.modn) { f32x4 hh = y * (1.f + sc) + sh; u32x2 o = {pack2(hh[0], hh[1]), pack2(hh[2], hh[3])}; *(u32x2*)(E.hout + off) = o; }
      if (E.modkv) { f32x4 hh = y * (1.f + sck) + shk; u32x2 o = {pack2(hh[0], hh[1]), pack2(hh[2], hh[3])}; *(u32x2*)(E.hkout + off) = o; }
    }
  }
}

DI void tile_coords(int t, int nN, int& pm, int& pn) {
  if (nN == 17) { if (t >= 2048) { pm = t - 2048; pn = 16; return; } nN = 16; }
  const int q = t >> 8, w = t & 255, x = w & 7, i = w >> 3;
  if (nN >= 16) { const int npn = nN >> 4; pm = (q / npn) * 16 + (x & 1) * 8 + (i & 7); pn = (q % npn) * 16 + (x >> 1) * 4 + (i >> 3); }
  else { pm = q * 32 + (x & 3) * 8 + (i & 7); pn = (x >> 2) * 4 + (i >> 3); }
}

template <class Epi>
DI void gemm_phase(const u16* A, const u16* Bt, int N, const Epi& E) {
  constexpr int K = 2048, BK = 64, KS = 2, TILE_B = 256 * BK * 2, GL = 4, STAGE_B = 2 * TILE_B, NT = K / BK;
  const int tid = tid_opq(), wid = tid >> 6, lane = tid & 63, wr = wid >> 2, wc = wid & 3, fr = lane & 15, fq = lane >> 4;
  unsigned soff[GL];
#pragma unroll
  for (int i = 0; i < GL; ++i) { int sR, sC; stage_rc<KS>(wid * 1024 + i * 8192 + lane * 16, sR, sC); soff[i] = (unsigned)((sR * K + sC) * 2); }
  const int nN = N >> 8, ntiles = 128 * nN;
#define SA(b) (shm + (b) * STAGE_B)
#define SB(b) (shm + (b) * STAGE_B + TILE_B)
#define GSRC(base, i, kt) ((const char*)((base) + (kt) * BK) + soff[i])
#define GLDS_STAGE(buf, kt, Ab_, Bb_) do { _Pragma("unroll") for (int i = 0; i < GL; ++i) { \
      __builtin_amdgcn_global_load_lds((const unsigned*)GSRC(Ab_, i, kt), (unsigned*)(SA(buf) + wid * 1024 + i * 8192), 16, 0, 0); \
      __builtin_amdgcn_global_load_lds((const unsigned*)GSRC(Bb_, i, kt), (unsigned*)(SB(buf) + wid * 1024 + i * 8192), 16, 0, 0); } } while (0)
  int t = bid_opq();
  if (t >= ntiles) return;
  int pm, pn;
  tile_coords(t, nN, pm, pn);
  const u16* Ab = A + (size_t)pm * 256 * K;
  const u16* Bb = Bt + (size_t)pn * 256 * K;
  GLDS_STAGE(0, 0, Ab, Bb); WAIT_V(0); __syncthreads();
  while (true) {
    const int brow = pm * 256, bcol = pn * 256;
    const int tn = t + gridDim.x;
    const u16* Abn = Ab; const u16* Bbn = Bb;
    if (tn < ntiles) { tile_coords(tn, nN, pm, pn); Abn = A + (size_t)pm * 256 * K; Bbn = Bt + (size_t)pn * 256 * K; }
    f32x4 acc[8][4];
#pragma unroll
    for (int m = 0; m < 8; ++m)
#pragma unroll
      for (int n = 0; n < 4; ++n) acc[m][n] = (f32x4){0.f, 0.f, 0.f, 0.f};
    for (int kt = 0; kt < NT; ++kt) {
      const int cur = kt & 1;
      if (kt + 1 < NT) GLDS_STAGE(cur ^ 1, kt + 1, Ab, Bb);
      else if (tn < ntiles) GLDS_STAGE(0, 0, Abn, Bbn);
#pragma unroll
      for (int ks = 0; ks < KS; ++ks) {
        bf16x8 At[8], Bf[4];
#pragma unroll
        for (int n = 0; n < 4; ++n) Bf[n] = *(const bf16x8*)(SB(cur) + lds_byte<KS>(wc * 64 + n * 16 + fr, ks * 32 + fq * 8));
#pragma unroll
        for (int m = 0; m < 8; ++m) At[m] = *(const bf16x8*)(SA(cur) + lds_byte<KS>(wr * 128 + m * 16 + fr, ks * 32 + fq * 8));
#pragma unroll
        for (int m = 0; m < 8; ++m)
#pragma unroll
          for (int n = 0; n < 4; ++n) acc[m][n] = __builtin_amdgcn_mfma_f32_16x16x32_bf16(Bf[n], At[m], acc[m][n], 0, 0, 0);
      }
      __builtin_amdgcn_sched_group_barrier(0x100, 8, 3);
#define SGB_M4R(nr) __builtin_amdgcn_sched_group_barrier(0x008, 4, 3); __builtin_amdgcn_sched_group_barrier(0x100, nr, 3);
      SGB_M4R(1) SGB_M4R(1) SGB_M4R(1) SGB_M4R(1) SGB_M4R(3) SGB_M4R(3)
      SGB_M4R(1) SGB_M4R(1) SGB_M4R(1) SGB_M4R(1) SGB_M4R(1) SGB_M4R(1)
      __builtin_amdgcn_sched_group_barrier(0x008, 16, 3);
#undef SGB_M4R
      __builtin_amdgcn_sched_barrier(0);
      if (kt + 1 < NT) { WAIT_V(0); __syncthreads(); }
    }
    gemm_epilogue(E, acc, brow, bcol, wr, wc, fr, fq, tid);
    WAIT_V(0); __syncthreads();
    if (tn >= ntiles) break;
    t = tn; Ab = Abn; Bb = Bbn;
  }
#undef SA
#undef SB
#undef GSRC
#undef GLDS_STAGE
}

template <bool DIFF, int NKB, int NDV, int KT, int KP, int VP>
DI void attn_tile(LAS char* sm, LAS char* Ks, LAS char* Vs, LAS char* cbs, int qoff, const bf16x8 (&qf_in)[8], f32x16 (&oacc)[NDV], float& mrow, float& lrow,
                  int k0, int t0, int tq0, int lane, int r, int h, int g, int qs, float scale2, float slope2) {
  bf16x8 qf[8];
#pragma unroll
  for (int ks = 0; ks < 8; ++ks) qf[ks] = qf_in[ks];
  f32x16 sacc[NKB];
#pragma unroll
  for (int kb = 0; kb < NKB; ++kb)
#pragma unroll
    for (int i = 0; i < 16; ++i) sacc[kb][i] = 0.f;
#pragma unroll
  for (int ks = 0; ks < 8; ++ks)
#pragma unroll
    for (int kb = 0; kb < NKB; ++kb) {
      bf16x8 a = *(LAS bf16x8*)(Ks + (kb * 32 + r) * KP + (g * 128 + ks * 16 + 8 * h) * 2);
      if (DIFF) qf[ks] = *(LAS bf16x8*)(sm + qoff + (qs * 32 + r) * KP + (g * 128 + ks * 16 + 8 * h) * 2);
      sacc[kb] = __builtin_amdgcn_mfma_f32_32x32x16_bf16(a, qf[ks], sacc[kb], 0, 0, 0);
    }
  {
    constexpr int RPM = DIFF ? 2 : 1, NM = 8 * NKB;
    __builtin_amdgcn_sched_group_barrier(0x100, 2 * RPM, 0);
#pragma unroll
    for (int jq = 0; jq < NM - 2; ++jq) { __builtin_amdgcn_sched_group_barrier(0x008, 1, 0); __builtin_amdgcn_sched_group_barrier(0x100, RPM, 0); }
    __builtin_amdgcn_sched_group_barrier(0x008, 2, 0);
  }
  float mx = -1e30f;
  const int dk = k0 + 4 * h - (tq0 + r);
  const float bias0 = DIFF ? slope2 * (float)(k0 + 4 * h - t0) : 0.f;
  if (k0 + KT - 1 > tq0) {
    asm volatile("" ::: "memory");
#pragma unroll
    for (int kb = 0; kb < NKB; ++kb)
#pragma unroll
      for (int a = 0; a < 4; ++a) {
        f32x4 cb4 = {0.f, 0.f, 0.f, 0.f};
        if (!DIFF) cb4 = *(LAS f32x4*)(cbs + (g * KT + kb * 32 + 8 * a + 4 * h) * 4);
#pragma unroll
        for (int jj = 0; jj < 4; ++jj) {
          const int off = kb * 32 + 8 * a + jj;
          float sv = __builtin_fmaf(sacc[kb][4 * a + jj], scale2, DIFF ? __builtin_fmaf((float)off, slope2, bias0) : cb4[jj]);
          if (dk + off > 0) sv = -1e30f;
          sacc[kb][4 * a + jj] = sv; mx = fmaxf(mx, sv);
        }
      }
  } else {
    asm volatile("" ::: "memory");
#pragma unroll
    for (int kb = 0; kb < NKB; ++kb)
#pragma unroll
      for (int a = 0; a < 4; ++a) {
        f32x4 cb4 = {0.f, 0.f, 0.f, 0.f};
        if (!DIFF) cb4 = *(LAS f32x4*)(cbs + (g * KT + kb * 32 + 8 * a + 4 * h) * 4);
#pragma unroll
        for (int jj = 0; jj < 4; ++jj) {
          const int off = kb * 32 + 8 * a + jj;
          float sv = __builtin_fmaf(sacc[kb][4 * a + jj], scale2, DIFF ? __builtin_fmaf((float)off, slope2, bias0) : cb4[jj]);
          sacc[kb][4 * a + jj] = sv; mx = fmaxf(mx, sv);
        }
      }
  }
  mx = xor32_max(mx);
  const float mnew = fmaxf(mrow, mx);
  const float alpha = __builtin_amdgcn_exp2f(mrow - mnew);
  mrow = mnew;
  float ps = 0.f;
#pragma unroll
  for (int kb = 0; kb < NKB; ++kb)
#pragma unroll
    for (int i = 0; i < 16; ++i) { float pv = __builtin_amdgcn_exp2f(sacc[kb][i] - mnew); sacc[kb][i] = pv; ps += pv; }
  lrow = lrow * alpha + ps;
  if (__any(alpha != 1.f)) {
#pragma unroll
    for (int d = 0; d < NDV; ++d)
#pragma unroll
      for (int i = 0; i < 16; ++i) oacc[d][i] *= alpha;
  }
  bf16x8 pf[NKB][2];
#pragma unroll
  for (int kb = 0; kb < NKB; ++kb)
#pragma unroll
    for (int s2 = 0; s2 < 2; ++s2) {
      u32x4 pk = {pack2(sacc[kb][8 * s2 + 0], sacc[kb][8 * s2 + 1]), pack2(sacc[kb][8 * s2 + 2], sacc[kb][8 * s2 + 3]),
                  pack2(sacc[kb][8 * s2 + 4], sacc[kb][8 * s2 + 5]), pack2(sacc[kb][8 * s2 + 6], sacc[kb][8 * s2 + 7])};
      pf[kb][s2] = __builtin_bit_cast(bf16x8, pk);
    }
  const int vrow = 4 * h + ((lane & 15) >> 2);
  const int vcol = (DIFF ? 0 : g * 128) + 16 * ((lane >> 4) & 1) + 4 * (lane & 3);
#pragma unroll
  for (int d = 0; d < NDV; ++d)
#pragma unroll
    for (int kb = 0; kb < NKB; ++kb)
#pragma unroll
      for (int s2 = 0; s2 < 2; ++s2) {
        LAS char* vp = Vs + (kb * 32 + 16 * s2 + vrow) * VP + (vcol + d * 32) * 2;
        s16x4 lo = __builtin_amdgcn_ds_read_tr16_b64_v4i16((LAS s16x4*)vp);
        s16x4 hi = __builtin_amdgcn_ds_read_tr16_b64_v4i16((LAS s16x4*)(vp + 8 * VP));
        bf16x8 a = __builtin_shufflevector(lo, hi, 0, 1, 2, 3, 4, 5, 6, 7);
        oacc[d] = __builtin_amdgcn_mfma_f32_32x32x16_bf16(a, pf[kb][s2], oacc[d], 0, 0, 0);
      }
  {
    constexpr int NM = NDV * NKB * 2;
    __builtin_amdgcn_sched_group_barrier(0x100, 4, 1);
#pragma unroll
    for (int jq = 0; jq < NM - 2; ++jq) { __builtin_amdgcn_sched_group_barrier(0x008, 1, 1); __builtin_amdgcn_sched_group_barrier(0x100, 2, 1); }
    __builtin_amdgcn_sched_group_barrier(0x008, 2, 1);
  }
}

template <bool DIFF>
DI void attn_phase(const u16* Qb, int ldq, const u16* Kb, int ldk, const u16* Vb, int ldv, const u16* Gb, int ldg,
                   u16* Ob, const float* Fcum, float lam, float outscale, const float* subln) {
  constexpr int KT = DIFF ? 32 : 64, NKB = KT / 32, NDV = DIFF ? 8 : 4;
  constexpr int KP = 528, VP = 576, STAGE = KT * (KP + VP), NLD = KT * 32 / 512, CB_OFF = 2 * STAGE, QOFF = 2 * STAGE;
  const float scale2 = 0.08838834764831845f * LOG2E;
  LAS char* sm = (LAS char*)shm;

  for (int j = bid_opq(); j < 2048; j += gridDim.x) {
    const int tid = tid_opq(), lane = tid & 63, wave = __builtin_amdgcn_readfirstlane(tid >> 6);
    const int r = lane & 31, h = lane >> 5, g = wave >> 2, qs = wave & 3;
    const int bid = j & 255, rr = j >> 8, hp = bid & 7, ii = bid >> 3;
    const int b = 2 * rr + (ii >> 4), qb = (rr & 1) ? 15 - (ii & 15) : (ii & 15);
    const int t0 = qb * 128, tq0 = t0 + qs * 32, ntile = (t0 + 128) / KT;
    const size_t rowbase = (size_t)b * S;

    bf16x8 qf[8];
    if (DIFF) {
#pragma unroll
      for (int i = 0; i < 8; ++i) {
        const int idx = tid + i * 512, row = idx >> 5, ch = idx & 31;
        *(LAS i32x4*)(sm + QOFF + row * KP + ch * 16) = *(const i32x4*)(Qb + (rowbase + t0 + row) * ldq + hp * 256 + ch * 8);
      }
#pragma unroll
      for (int ks = 0; ks < 8; ++ks) qf[ks] = (bf16x8){0, 0, 0, 0, 0, 0, 0, 0};
    } else {
      const u16* qp = Qb + (rowbase + tq0 + r) * ldq + hp * 256 + g * 128 + 8 * h;
#pragma unroll
      for (int ks = 0; ks < 8; ++ks) qf[ks] = *(const bf16x8*)(qp + ks * 16);
    }
    f32x16 oacc[NDV];
#pragma unroll
    for (int d = 0; d < NDV; ++d)
#pragma unroll
      for (int i = 0; i < 16; ++i) oacc[d][i] = 0.f;
    float mrow = -1e30f, lrow = 0.f;
    const float slope2 = DIFF ? exp2f(-(float)(hp + 1)) * LOG2E : 0.f;
    const float* Fp = nullptr; float Ft0 = 0.f;
    if (!DIFF && tid < 2 * KT) { Fp = Fcum + ((size_t)(b * 16 + 2 * hp + tid / KT)) * S; Ft0 = Fp[t0]; }

    const unsigned koff = (unsigned)(((tid >> 5) * ldk + (tid & 31) * 8) * 2), voff = (unsigned)(((tid >> 5) * ldv + (tid & 31) * 8) * 2);
#define AT_ISSUE(KR, VR, CR, kt) do { const int k0_ = (kt) * KT; \
      const char* kbase_ = (const char*)(Kb + (rowbase + k0_) * ldk + hp * 256); \
      const char* vbase_ = (const char*)(Vb + (rowbase + k0_) * ldv + hp * 256); \
      _Pragma("unroll") for (int i = 0; i < NLD; ++i) { \
      KR[i] = *(const i32x4*)(kbase_ + (size_t)i * 16 * ldk * 2 + koff); \
      VR[i] = *(const i32x4*)(vbase_ + (size_t)i * 16 * ldv * 2 + voff); } \
      if (!DIFF && tid < 2 * KT) CR = (Ft0 - Fp[k0_ + (tid % KT)]) * LOG2E; } while (0)
#define AT_WRITE(KR, VR, CR, st) do { _Pragma("unroll") for (int i = 0; i < NLD; ++i) { \
      const int idx = tid + i * 512, row = idx >> 5, ch = idx & 31; \
      *(LAS i32x4*)(sm + (st) * STAGE + row * KP + ch * 16) = KR[i]; \
      *(LAS i32x4*)(sm + (st) * STAGE + KT * KP + row * VP + ch * 16) = VR[i]; } \
      if (!DIFF && tid < 2 * KT) *(LAS float*)(sm + CB_OFF + ((st) * 2 * KT + tid) * 4) = CR; } while (0)
#define AT_COMPUTE(it_, st) do { const int k0c_ = (ntile - 1 - (it_)) * KT; if (k0c_ <= tq0 + 31) \
      attn_tile<DIFF, NKB, NDV, KT, KP, VP>(sm, sm + (st) * STAGE, sm + (st) * STAGE + KT * KP, sm + CB_OFF + (st) * 2 * KT * 4, QOFF, qf, oacc, mrow, lrow, \
                                             k0c_, t0, tq0, lane, r, h, g, qs, scale2, slope2); } while (0)
    i32x4 kregA[NLD], vregA[NLD]; float cbregA = 0.f;
    {
      i32x4 kregB[NLD], vregB[NLD]; float cbregB = 0.f;
      AT_ISSUE(kregA, vregA, cbregA, ntile - 1); AT_WRITE(kregA, vregA, cbregA, 0);
      AT_ISSUE(kregA, vregA, cbregA, max(ntile - 2, 0));
      AT_ISSUE(kregB, vregB, cbregB, max(ntile - 3, 0));
      __syncthreads();
      for (int it = 0; it < ntile; it += 2) {
        AT_COMPUTE(it, 0);
        AT_WRITE(kregA, vregA, cbregA, 1);
        AT_ISSUE(kregA, vregA, cbregA, max(ntile - 4 - it, 0));
        __syncthreads();
        AT_COMPUTE(it + 1, 1);
        AT_WRITE(kregB, vregB, cbregB, 0);
        AT_ISSUE(kregB, vregB, cbregB, max(ntile - 5 - it, 0));
        __syncthreads();
      }
    }
#undef AT_ISSUE
#undef AT_WRITE
#undef AT_COMPUTE
    int lo_ = lane; asm volatile("" : "+v"(lo_));
    const int h_ = lo_ >> 5, r_ = lo_ & 31;
    const float ltot = lrow + __shfl_xor(lrow, 32);
    const float inv = 1.f / ltot;
    const size_t orow = rowbase + tq0 + r_;
    const int cbase = hp * 256 + (DIFF ? 0 : g * 128) + 4 * h_;
    const u16* gptr = Gb + orow * ldg + cbase;
    u16* optr = Ob + orow * D + cbase;
    if (!DIFF) {
#pragma unroll
      for (int d = 0; d < NDV; ++d)
#pragma unroll
        for (int a = 0; a < 4; ++a) {
          u32x2 gz = *(const u32x2*)(gptr + d * 32 + 8 * a);
          float o0 = oacc[d][4 * a + 0] * inv * silu_f(bf_lo(gz[0]));
          float o1 = oacc[d][4 * a + 1] * inv * silu_f(bf_hi(gz[0]));
          float o2 = oacc[d][4 * a + 2] * inv * silu_f(bf_lo(gz[1]));
          float o3 = oacc[d][4 * a + 3] * inv * silu_f(bf_hi(gz[1]));
          u32x2 o = {pack2(o0, o1), pack2(o2, o3)};
          *(u32x2*)(optr + d * 32 + 8 * a) = o;
        }
    } else {
      constexpr int IP = 1040;
      LAS char* img = sm + (qs * 32 + r_) * IP + 16 * h_;
      LAS float* rnorm = (LAS float*)(sm + 128 * IP);
      if (g == 1) {
        const float sc = lam * inv;
#pragma unroll
        for (int d = 0; d < NDV; ++d)
#pragma unroll
          for (int a = 0; a < 4; ++a) {
            f32x4 v = {oacc[d][4 * a] * sc, oacc[d][4 * a + 1] * sc, oacc[d][4 * a + 2] * sc, oacc[d][4 * a + 3] * sc};
            *(LAS f32x4*)(img + (d * 32 + 8 * a) * 4) = v;
          }
      }
      __syncthreads();
      if (g == 0) {
        float ss = 0.f;
#pragma unroll
        for (int d = 0; d < NDV; ++d)
#pragma unroll
          for (int a = 0; a < 4; ++a) {
            LAS f32x4* pp = (LAS f32x4*)(img + (d * 32 + 8 * a) * 4);
            const f32x4 x4 = *pp;
            f32x4 dv;
#pragma unroll
            for (int jj = 0; jj < 4; ++jj) { dv[jj] = oacc[d][4 * a + jj] * inv - x4[jj]; ss = __builtin_fmaf(dv[jj], dv[jj], ss); }
            *pp = dv;
          }
        ss += __shfl_xor(ss, 32);
        if (h_ == 0) rnorm[qs * 32 + r_] = rsqrtf(ss * (1.f / 256.f) + EPS) * outscale;
      }
      __syncthreads();
      {
        int t2 = tid; asm volatile("" : "+v"(t2));
        const int c8 = t2 & 31, rg = t2 >> 5;
        const f32x4 sg0 = *(const f32x4*)(subln + c8 * 8), sg1 = *(const f32x4*)(subln + c8 * 8 + 4);
        const u16* gp2 = Gb + (rowbase + t0 + rg) * ldg + hp * 256 + c8 * 8;
        u16* op2 = Ob + (rowbase + t0 + rg) * D + hp * 256 + c8 * 8;
        LAS char* ip2 = sm + rg * IP + c8 * 32;
#pragma unroll
        for (int i = 0; i < 8; ++i) {
          const u32x4 gz = *(const u32x4*)(gp2 + (size_t)i * 16 * ldg);
          const f32x4 d0 = *(LAS f32x4*)(ip2 + i * 16 * IP), d1 = *(LAS f32x4*)(ip2 + i * 16 * IP + 16);
          const float rn = rnorm[rg + 16 * i];
          u32x4 o;
          o[0] = pack2(d0[0] * rn * sg0[0] * silu_f(bf_lo(gz[0])), d0[1] * rn * sg0[1] * silu_f(bf_hi(gz[0])));
          o[1] = pack2(d0[2] * rn * sg0[2] * silu_f(bf_lo(gz[1])), d0[3] * rn * sg0[3] * silu_f(bf_hi(gz[1])));
          o[2] = pack2(d1[0] * rn * sg1[0] * silu_f(bf_lo(gz[2])), d1[1] * rn * sg1[1] * silu_f(bf_hi(gz[2])));
          o[3] = pack2(d1[2] * rn * sg1[2] * silu_f(bf_lo(gz[3])), d1[3] * rn * sg1[3] * silu_f(bf_hi(gz[3])));
          __builtin_nontemporal_store(o, (u32x4*)(op2 + (size_t)i * 16 * D));
        }
      }
      __syncthreads();
    }
  }
}

DI void attn_fox_phase(const u16* Qb, int ldq, const u16* Kb, int ldk, const u16* Vb, int ldv, const u16* Gb, int ldg, u16* Ob, const float* Fcum) {
  constexpr int KT = 64, NKB = 2, NDV = 4, KP = 272, VP = 320, STAGE = KT * (KP + VP), CB_OFF = 2 * STAGE, NLD = 2;
  const float scale2 = 0.08838834764831845f * LOG2E;
  LAS char* sm = (LAS char*)shm;
  for (int j = bid_opq(); j < 2048; j += gridDim.x) {
    const int tid = tid_opq(), lane = tid & 63, wave = __builtin_amdgcn_readfirstlane(tid >> 6);
    const int r = lane & 31, h = lane >> 5, qs = wave;
    const int bid = j & 255, rr = j >> 8, xx = bid & 7, ii = bid >> 3;
    const int head = xx + 8 * ((ii >> 3) & 1), b = 2 * rr + (ii >> 4), qb = (rr & 1) ? 7 - (ii & 7) : (ii & 7);
    const int t0 = qb * 256, tq0 = t0 + qs * 32, ntile = (t0 + 256) / KT;
    const size_t rowbase = (size_t)b * S;
    bf16x8 qf[8];
    {
      const u16* qp = Qb + (rowbase + tq0 + r) * ldq + head * 128 + 8 * h;
#pragma unroll
      for (int ks = 0; ks < 8; ++ks) qf[ks] = *(const bf16x8*)(qp + ks * 16);
    }
    f32x16 oacc[NDV];
#pragma unroll
    for (int d = 0; d < NDV; ++d)
#pragma unroll
      for (int i = 0; i < 16; ++i) oacc[d][i] = 0.f;
    float mrow = -1e30f, lrow = 0.f;
    const float* Fp = Fcum + ((size_t)(b * 16 + head)) * S + (tid & 63);
    const float Ft0 = Fp[t0 - (tid & 63)];
    const unsigned koff = (unsigned)(((tid >> 4) * ldk + (tid & 15) * 8) * 2), voff = (unsigned)(((tid >> 4) * ldv + (tid & 15) * 8) * 2);
#define FX_ISSUE(KR, VR, CR, kt) do { const int k0_ = (kt) * KT; \
      const char* kbase_ = (const char*)(Kb + (rowbase + k0_) * ldk + head * 128); \
      const char* vbase_ = (const char*)(Vb + (rowbase + k0_) * ldv + head * 128); \
      _Pragma("unroll") for (int i = 0; i < NLD; ++i) { \
      KR[i] = *(const i32x4*)(kbase_ + (size_t)i * 32 * ldk * 2 + koff); \
      VR[i] = *(const i32x4*)(vbase_ + (size_t)i * 32 * ldv * 2 + voff); } \
      CR = (Ft0 - Fp[k0_]) * LOG2E; } while (0)
#define FX_WRITE(KR, VR, CR, st) do { _Pragma("unroll") for (int i = 0; i < NLD; ++i) { \
      const int idx = tid + i * 512, row = idx >> 4, ch = idx & 15; \
      *(LAS i32x4*)(sm + (st) * STAGE + row * KP + ch * 16) = KR[i]; \
      *(LAS i32x4*)(sm + (st) * STAGE + KT * KP + row * VP + ch * 16) = VR[i]; } \
      if (tid < KT) *(LAS float*)(sm + CB_OFF + ((st) * KT + tid) * 4) = CR; } while (0)
#define FX_COMPUTE(it_, st) do { const int k0c_ = (ntile - 1 - (it_)) * KT; if (k0c_ <= tq0 + 31) \
      attn_tile<false, NKB, NDV, KT, KP, VP>(sm, sm + (st) * STAGE, sm + (st) * STAGE + KT * KP, sm + CB_OFF + (st) * KT * 4, 0, qf, oacc, mrow, lrow, \
                                              k0c_, t0, tq0, lane, r, h, 0, qs, scale2, 0.f); } while (0)
    i32x4 kregA[NLD], vregA[NLD], kregB[NLD], vregB[NLD]; float cbregA = 0.f, cbregB = 0.f;
    FX_ISSUE(kregA, vregA, cbregA, ntile - 1); FX_WRITE(kregA, vregA, cbregA, 0);
    FX_ISSUE(kregA, vregA, cbregA, max(ntile - 2, 0));
    FX_ISSUE(kregB, vregB, cbregB, max(ntile - 3, 0));
    __syncthreads();
    for (int it = 0; it < ntile; it += 2) {
      FX_COMPUTE(it, 0);
      FX_WRITE(kregA, vregA, cbregA, 1);
      FX_ISSUE(kregA, vregA, cbregA, max(ntile - 4 - it, 0));
      __syncthreads();
      FX_COMPUTE(it + 1, 1);
      FX_WRITE(kregB, vregB, cbregB, 0);
      FX_ISSUE(kregB, vregB, cbregB, max(ntile - 5 - it, 0));
      __syncthreads();
    }
#undef FX_ISSUE
#undef FX_WRITE
#undef FX_COMPUTE
    int lo_ = lane; asm volatile("" : "+v"(lo_));
    const int h_ = lo_ >> 5, r_ = lo_ & 31;
    const float ltot = lrow + __shfl_xor(lrow, 32);
    const float inv = 1.f / ltot;
    constexpr int IP = 528;
    {
      LAS char* img = sm + (qs * 32 + r_) * IP + 16 * h_;
#pragma unroll
      for (int d = 0; d < NDV; ++d)
#pragma unroll
        for (int a = 0; a < 4; ++a) {
          f32x4 v = {oacc[d][4 * a] * inv, oacc[d][4 * a + 1] * inv, oacc[d][4 * a + 2] * inv, oacc[d][4 * a + 3] * inv};
          *(LAS f32x4*)(img + (d * 32 + 8 * a) * 4) = v;
        }
    }
    __syncthreads();
    {
      int t2 = tid; asm volatile("" : "+v"(t2));
      const int c8 = t2 & 15, rg = t2 >> 4;
      const u16* gp2 = Gb + (rowbase + t0 + rg) * ldg + head * 128 + c8 * 8;
      u16* op2 = Ob + (rowbase + t0 + rg) * D + head * 128 + c8 * 8;
      LAS char* ip2 = sm + rg * IP + c8 * 32;
#pragma unroll
      for (int i = 0; i < 8; ++i) {
        const u32x4 gz = *(const u32x4*)(gp2 + (size_t)i * 32 * ldg);
        const f32x4 d0 = *(LAS f32x4*)(ip2 + i * 32 * IP), d1 = *(LAS f32x4*)(ip2 + i * 32 * IP + 16);
        u32x4 o;
        o[0] = pack2(d0[0] * silu_f(bf_lo(gz[0])), d0[1] * silu_f(bf_hi(gz[0])));
        o[1] = pack2(d0[2] * silu_f(bf_lo(gz[1])), d0[3] * silu_f(bf_hi(gz[1])));
        o[2] = pack2(d1[0] * silu_f(bf_lo(gz[2])), d1[1] * silu_f(bf_hi(gz[2])));
        o[3] = pack2(d1[2] * silu_f(bf_lo(gz[3])), d1[3] * silu_f(bf_hi(gz[3])));
        __builtin_nontemporal_store(o, (u32x4*)(op2 + (size_t)i * 32 * D));
      }
    }
    __syncthreads();
  }
}

DI void grid_bar(unsigned* ctr, unsigned target) {
  asm volatile("s_waitcnt vmcnt(0) lgkmcnt(0)" ::: "memory");
  __syncthreads();
  if (threadIdx.x == 0) {
    __builtin_amdgcn_fence(__ATOMIC_RELEASE, "agent");
    asm volatile("s_waitcnt vmcnt(0)" ::: "memory");
    __hip_atomic_fetch_add(ctr, 1u, __ATOMIC_RELAXED, __HIP_MEMORY_SCOPE_AGENT);
    unsigned spins = 0;
    while (__hip_atomic_load(ctr, __ATOMIC_RELAXED, __HIP_MEMORY_SCOPE_AGENT) < target && ++spins < (1u << 24)) __builtin_amdgcn_s_sleep(2);
    __builtin_amdgcn_fence(__ATOMIC_ACQUIRE, "agent");
    asm volatile("s_waitcnt vmcnt(0)" ::: "memory");
  }
  __syncthreads();
}

__global__ void __launch_bounds__(512, 2) mk_fwd(Params p_arg) {
  cg::grid_group grid = cg::this_grid();
  typedef __attribute__((address_space(4))) const Params* KP;
  KP kp0 = (KP)__builtin_amdgcn_kernarg_segment_ptr();
  Params p;
  p.ws = kp0->ws; p.ph_lo = kp0->ph_lo; p.ph_hi = kp0->ph_hi;
  char* ws = p.ws;
  float* modf = (float*)(ws + WS_MODF);
  u16* hb = (u16*)(ws + WS_H);
  u16* proj = (u16*)(ws + WS_PROJ);
  u16* kvb = proj + (size_t)M * 4096;
  unsigned* bar = (unsigned*)(ws + WS_BAR);
  if (blockIdx.x == 0 && threadIdx.x < 256) __hip_atomic_store(bar + threadIdx.x, 0u, __ATOMIC_RELAXED, __HIP_MEMORY_SCOPE_AGENT);
  unsigned nbar = 0;
  for (int ph = p.ph_lo; ph < p.ph_hi; ++ph) {
    if (ph == p.ph_lo + 1) grid.sync();
    else if (ph > p.ph_lo + 1) { ++nbar; grid_bar(bar, nbar * gridDim.x); }
    { KP q_ = kp0; asm volatile("" : "+s"(q_)); const int lo_ = p.ph_lo, hi_ = p.ph_hi; p = *(const Params*)q_; p.ph_lo = lo_; p.ph_hi = hi_; }
    if (ph == 0) phase0(p);
    else if (ph == 1) phase_modfin(p);
    else if (ph == 2) phase_modulate0(p);
    else if (ph == 9) {
      EpiStore E{kvb, 4096, 4096, (float*)(ws + WS_ZF)};
      gemm_phase(proj  , (const u16*)(ws + WS_WT_KV), 4352, E);
    } else {
      const bool isA = ph < 9;
      const int q = isA ? ph - 3 : ph - 10, li = q / 3, sub = q % 3, l = isA ? li : 2 + li;
      if (sub == 0) {
        if (l == 2) { phase_fscan(p); }
        const u16* Bt = isA ? (const u16*)(ws + WS_WT_AIN) + (size_t)li * 8192 * 2048 : (const u16*)(ws + WS_WT_BIN) + (size_t)li * 4096 * 2048;
        const int N = isA ? 8192 : 4096;
        EpiStore E{proj, N, N, nullptr};
        gemm_phase(hb, Bt, N, E);
      } else if (sub == 1) {
        if (isA) {
          const int lane = tid_opq() & 63;
          float s1 = p.lq1[l * 128 + lane] * p.lk1[l * 128 + lane] + p.lq1[l * 128 + 64 + lane] * p.lk1[l * 128 + 64 + lane];
          float s2 = p.lq2[l * 128 + lane] * p.lk2[l * 128 + lane] + p.lq2[l * 128 + 64 + lane] * p.lk2[l * 128 + 64 + lane];
          s1 = wave_sum(s1); s2 = wave_sum(s2);
          const float lam_init = 0.8f - 0.6f * expf(-0.3f * (float)l);
          const float lam = expf(s1) - expf(s2) + lam_init;
          attn_phase<true>(proj, 8192, proj + 2048, 8192, proj + 4096, 8192, proj + 6144, 8192, hb, nullptr, lam, 1.f - lam_init, p.subln + l * 256);
        } else {
          attn_fox_phase(proj, 4096, kvb, 4096, kvb + 2048, 4096, proj + 2048, 4096, hb, (const float*)(ws + WS_FCUM));
        }
      } else {
        const u16* Bt = isA ? (const u16*)(ws + WS_WT_AOUT) + (size_t)li * 2048 * 2048 : (const u16*)(ws + WS_WT_BOUT) + (size_t)li * 2048 * 2048;
        EpiResid E{l == 0 ? p.x : p.out, p.out, modf + l * 6144 + 4096, p.ln_g + l * 2048, p.ln_b + l * 2048,
                   l < 3 ? modf + (l + 1) * 6144 : nullptr, hb, l == 1 ? modf + 24576 : nullptr, proj,
                   (float*)(ws + WS_STATS), bar + 64, 8u * (unsigned)(l + 1)};
        gemm_phase(hb, Bt, 2048, E);
      }
    }
  }
}

extern "C" void kernel_launch(void* const* d_in, const int* in_sizes, int n_in, void* d_out, int out_size, void* d_ws, size_t ws_size,
                              hipStream_t stream) {
  static int grid = 0;
  if (grid == 0) {
    if (ws_size < WS_END) { fprintf(stderr, "kernel_launch: workspace too small: %zu < %zu\n", ws_size, (size_t)WS_END); grid = -1; return; }
    int dev = 0, cus = 0, per_cu = 0;
    hipGetDevice(&dev);
    hipDeviceGetAttribute(&cus, hipDeviceAttributeMultiprocessorCount, dev);
    if (hipFuncSetAttribute((const void*)mk_fwd, hipFuncAttributeMaxDynamicSharedMemorySize, LDS_BYTES) != hipSuccess) { fprintf(stderr, "kernel_launch: hipFuncSetAttribute failed\n"); grid = -1; return; }
    if (hipOccupancyMaxActiveBlocksPerMultiprocessor(&per_cu, (const void*)mk_fwd, 512, LDS_BYTES) != hipSuccess || per_cu < 1) per_cu = 1;
    (void)hipGetLastError();
    grid = cus * per_cu;
    fprintf(stderr, "kernel_launch: cus %d per_cu %d grid %d\n", cus, per_cu, grid);
  }
  if (grid < 0) return;
  Params p{};
  p.x = (const float*)d_in[0]; p.c = (const float*)d_in[1]; p.w_mod = (const float*)d_in[2]; p.b_mod = (const float*)d_in[3];
  p.ln_g = (const float*)d_in[4]; p.ln_b = (const float*)d_in[5]; p.a_w_in = (const float*)d_in[6]; p.a_w_out = (const float*)d_in[7];
  p.lq1 = (const float*)d_in[8]; p.lk1 = (const float*)d_in[9]; p.lq2 = (const float*)d_in[10]; p.lk2 = (const float*)d_in[11];
  p.subln = (const float*)d_in[12]; p.kv_w_mod = (const float*)d_in[13]; p.kv_b_mod = (const float*)d_in[14]; p.kv_w = (const float*)d_in[15];
  p.kv_b_f = (const float*)d_in[16]; p.b_w_in = (const float*)d_in[17]; p.b_w_out = (const float*)d_in[18];
  p.out = (float*)d_out; p.ws = (char*)d_ws;
  p.ph_lo = 0; p.ph_hi = NPHASE;
  void* args[] = {&p};
  hipError_t e = hipLaunchCooperativeKernel((void*)mk_fwd, dim3(grid), dim3(512), args, LDS_BYTES, stream);
  if (e != hipSuccess) fprintf(stderr, "cooperative launch failed: %s (grid %d)\n", hipGetErrorString(e), grid);
}
```

```cpp
#include <hip/hip_runtime.h>
#include <hip/hip_cooperative_groups.h>
#include <cstdio>
namespace cg = cooperative_groups;

#ifndef MK_MULTI
#define MK_MULTI 0
#endif

typedef unsigned short u16;
using bf16x8 = __attribute__((ext_vector_type(8))) short;
using s16x4  = __attribute__((ext_vector_type(4))) short;
using f32x4  = __attribute__((ext_vector_type(4))) float;
using f32x16 = __attribute__((ext_vector_type(16))) float;
using i32x4  = __attribute__((ext_vector_type(4))) int;
using u32x2  = __attribute__((ext_vector_type(2))) unsigned;
using u32x4  = __attribute__((ext_vector_type(4))) unsigned;
typedef __attribute__((ext_vector_type(2))) __bf16 bf2_t;
typedef __attribute__((ext_vector_type(2))) float f2_t;
#define LAS __attribute__((address_space(3)))
#define DI __device__ __forceinline__
#ifndef REP_A
#define REP_A 1
#endif
#ifndef REP_B
#define REP_B 1
#endif
#ifndef REP_G
#define REP_G 1
#endif

constexpr int D = 2048, NBATCH = 16, S = 2048, M = NBATCH * S;
constexpr int MODW = 28672;
constexpr int KSPLIT = 16;
constexpr float LOG2E = 1.4426950408889634f;
constexpr float DN_ALPHA = 1.681792830507429f;
constexpr float EPS = 1e-5f;

constexpr size_t WS_WT_AIN  = 0;
constexpr size_t WS_WT_AOUT = WS_WT_AIN  + (size_t)2 * 8192 * 2048 * 2;
constexpr size_t WS_WT_KV   = WS_WT_AOUT + (size_t)2 * 2048 * 2048 * 2;
constexpr size_t WS_WT_BIN  = WS_WT_KV   + (size_t)4352 * 2048 * 2;
constexpr size_t WS_WT_BOUT = WS_WT_BIN  + (size_t)2 * 4096 * 2048 * 2;
constexpr size_t WS_PART    = WS_WT_BOUT + (size_t)2 * 2048 * 2048 * 2;
constexpr size_t WS_MODF    = WS_PART    + (size_t)KSPLIT * 16 * MODW * 4;
constexpr size_t WS_ZF      = WS_MODF    + (size_t)16 * MODW * 4;
constexpr size_t WS_FCUM    = WS_ZF      + (size_t)M * 16 * 4;
constexpr size_t WS_H       = WS_FCUM    + (size_t)M * 16 * 4;
constexpr size_t WS_PROJ    = WS_H       + (size_t)M * 2048 * 2;
constexpr size_t WS_BAR     = WS_PROJ    + (size_t)M * 8192 * 2;
constexpr size_t WS_STATS   = WS_BAR     + 4096;
constexpr size_t WS_END     = WS_STATS   + (size_t)128 * 8 * 256 * 8;

constexpr int LDS_BYTES = 2 * 64 * (528 + 576) + 2 * 2 * 64 * 4;
constexpr int NPHASE = 16;

struct Params {
  const float *x, *c, *w_mod, *b_mod, *ln_g, *ln_b, *a_w_in, *a_w_out, *lq1, *lk1, *lq2, *lk2, *subln,
              *kv_w_mod, *kv_b_mod, *kv_w, *kv_b_f, *b_w_in, *b_w_out;
  float* out; char* ws; int ph_lo, ph_hi;
};

extern __shared__ __attribute__((aligned(1024))) char shm[];

DI unsigned pack2(float a, float b) { f2_t v = {a, b}; bf2_t r = __builtin_convertvector(v, bf2_t); return __builtin_bit_cast(unsigned, r); }
DI float bf_lo(unsigned u) { return __uint_as_float(u << 16); }
DI float bf_hi(unsigned u) { return __uint_as_float(u & 0xffff0000u); }
DI float silu_f(float x) { return x / (1.f + __expf(-x)); }
DI int tid_opq() { int t = threadIdx.x; asm volatile("" : "+v"(t)); return t; }
DI int bid_opq() { int b = blockIdx.x; asm volatile("" : "+s"(b)); return b; }
DI float xor32_max(float x) {
  auto r = __builtin_amdgcn_permlane32_swap(__float_as_uint(x), __float_as_uint(x), false, false);
  return fmaxf(__uint_as_float(r[0]), __uint_as_float(r[1]));
}
DI float wave_sum(float v) {
#pragma unroll
  for (int o = 32; o >= 1; o >>= 1) v += __shfl_xor(v, o);
  return v;
}

DI void convert_tile(const float* __restrict__ W, int N, u16* __restrict__ Wt, int tk, int tn) {
  float* tile = (float*)shm;
  const int tid = tid_opq(), k0 = tk * 64, n0 = tn * 64;
#pragma unroll
  for (int i = 0; i < 2; ++i) {
    int kk = (tid >> 4) + 32 * i, c4 = (tid & 15) * 4, n = n0 + c4;
    f32x4 v = {0.f, 0.f, 0.f, 0.f};
    if (n < N) v = *(const f32x4*)(W + (size_t)(k0 + kk) * N + n);
    tile[kk * 65 + c4 + 0] = v[0]; tile[kk * 65 + c4 + 1] = v[1]; tile[kk * 65 + c4 + 2] = v[2]; tile[kk * 65 + c4 + 3] = v[3];
  }
  __syncthreads();
  {
    int n = tid >> 3, ks = tid & 7;
    float f[8];
#pragma unroll
    for (int j = 0; j < 8; ++j) f[j] = tile[(ks * 8 + j) * 65 + n];
    u32x4 o = {pack2(f[0], f[1]), pack2(f[2], f[3]), pack2(f[4], f[5]), pack2(f[6], f[7])};
    *(u32x4*)(Wt + (size_t)(n0 + n) * 2048 + k0 + ks * 8) = o;
  }
  __syncthreads();
}

DI void mod_task(const Params& p, int task) {
  float* cact = (float*)shm;
  float* part = (float*)(p.ws + WS_PART);
  const int tid = tid_opq();
  const int ks = task / 14, cgp = task % 14, k0 = ks * 128;
  const int c = (cgp * 512 + tid) * 4;
  const float* W; int N, lc;
  if (c < 24576) { int set = c / 6144; W = p.w_mod + (size_t)set * 2048 * 6144; N = 6144; lc = c - set * 6144; }
  else { W = p.kv_w_mod; N = 4096; lc = c - 24576; }
  for (int idx = tid; idx < 128 * 16; idx += 512) {
    int kk = idx & 127, b = idx >> 7;
    float v = p.c[b * 2048 + k0 + kk];
    cact[kk * 16 + b] = silu_f(v);
  }
  __syncthreads();
  f32x4 acc[16];
#pragma unroll
  for (int b = 0; b < 16; ++b) acc[b] = (f32x4){0.f, 0.f, 0.f, 0.f};
  const float* wp = W + (size_t)k0 * N + lc;
#pragma unroll 4
  for (int kk = 0; kk < 128; ++kk) {
    f32x4 w = *(const f32x4*)(wp + (size_t)kk * N);
#pragma unroll
    for (int q = 0; q < 4; ++q) {
      f32x4 cv = *(const f32x4*)(cact + kk * 16 + q * 4);
#pragma unroll
      for (int e = 0; e < 4; ++e) acc[q * 4 + e] += cv[e] * w;
    }
  }
#pragma unroll
  for (int b = 0; b < 16; ++b) *(f32x4*)(part + (size_t)(ks * 16 + b) * MODW + c) = acc[b];
  __syncthreads();
}

DI void phase0(const Params& p) {
  constexpr int NMOD = 14 * KSPLIT;
  constexpr int NCONV = 8192 + 2048 + 2080 + 4096 + 2048;
  for (int u = bid_opq(); u < NMOD + NCONV; u += gridDim.x) {
    if (u < NMOD) { mod_task(p, u); continue; }
    int t = u - NMOD;
    const float* W; u16* Wt; int N, ntn;
    if (t < 8192) { int l = t >> 12; t &= 4095; W = p.a_w_in + (size_t)l * 2048 * 8192; Wt = (u16*)(p.ws + WS_WT_AIN) + (size_t)l * 8192 * 2048; N = 8192; ntn = 128; }
    else if (t < 8192 + 2048) { t -= 8192; int l = t >> 10; t &= 1023; W = p.a_w_out + (size_t)l * 2048 * 2048; Wt = (u16*)(p.ws + WS_WT_AOUT) + (size_t)l * 2048 * 2048; N = 2048; ntn = 32; }
    else if (t < 8192 + 2048 + 2080) { t -= 8192 + 2048; W = p.kv_w; Wt = (u16*)(p.ws + WS_WT_KV); N = 4112; ntn = 65; }
    else if (t < 8192 + 2048 + 2080 + 4096) { t -= 8192 + 2048 + 2080; int l = t >> 11; t &= 2047; W = p.b_w_in + (size_t)l * 2048 * 4096; Wt = (u16*)(p.ws + WS_WT_BIN) + (size_t)l * 4096 * 2048; N = 4096; ntn = 64; }
    else { t -= 8192 + 2048 + 2080 + 4096; int l = t >> 10; t &= 1023; W = p.b_w_out + (size_t)l * 2048 * 2048; Wt = (u16*)(p.ws + WS_WT_BOUT) + (size_t)l * 2048 * 2048; N = 2048; ntn = 32; }
    convert_tile(W, N, Wt, t / ntn, t % ntn);
  }
}

DI void phase_modfin(const Params& p) {
  const float* part = (const float*)(p.ws + WS_PART);
  float* modf = (float*)(p.ws + WS_MODF);
  for (int idx = bid_opq() * 512 + tid_opq(); idx < 16 * (MODW / 4); idx += gridDim.x * 512) {
    int b = idx / (MODW / 4), c = (idx % (MODW / 4)) * 4;
    f32x4 s = (c < 24576) ? *(const f32x4*)(p.b_mod + c) : *(const f32x4*)(p.kv_b_mod + (c - 24576));
#pragma unroll
    for (int ks = 0; ks < KSPLIT; ++ks) s += *(const f32x4*)(part + (size_t)(ks * 16 + b) * MODW + c);
    *(f32x4*)(modf + (size_t)b * MODW + c) = s;
  }
}

DI void phase_modulate0(const Params& p) {
  const float* modf = (const float*)(p.ws + WS_MODF);
  u16* hb = (u16*)(p.ws + WS_H);
  const int tid_ = tid_opq(), lane = tid_ & 63, wave = tid_ >> 6;
  for (int row = bid_opq() * 8 + wave; row < M; row += gridDim.x * 8) {
    const int b = row >> 11;
#pragma unroll
    for (int i = 0; i < 8; ++i) {
      int col = (i * 64 + lane) * 4;
      f32x4 v = *(const f32x4*)(p.x + (size_t)row * D + col);
      f32x4 sh = *(const f32x4*)(modf + (size_t)b * MODW + col);
      f32x4 sc = *(const f32x4*)(modf + (size_t)b * MODW + 2048 + col);
      f32x4 h = v * (1.f + sc) + sh;
      u32x2 o = {pack2(h[0], h[1]), pack2(h[2], h[3])};
      *(u32x2*)(hb + (size_t)row * D + col) = o;
    }
  }
}

DI void phase_ln(float* xio, const float* __restrict__ lng, const float* __restrict__ lnb,
                 const float* modn, u16* hout, const float* modkv, u16* hkout) {
  const int tid_ = tid_opq(), lane = tid_ & 63, wave = tid_ >> 6;
  for (int row0 = (bid_opq() * 8 + wave) * 2; row0 < M; row0 += gridDim.x * 16) {
    const int b = row0 >> 11;
    f32x4 v[2][8];
    float s[2] = {0.f, 0.f};
#pragma unroll
    for (int rr = 0; rr < 2; ++rr)
#pragma unroll
      for (int i = 0; i < 8; ++i) v[rr][i] = *(const f32x4*)(xio + (size_t)(row0 + rr) * D + (i * 64 + lane) * 4);
#pragma unroll
    for (int rr = 0; rr < 2; ++rr)
#pragma unroll
      for (int i = 0; i < 8; ++i) s[rr] += v[rr][i][0] + v[rr][i][1] + v[rr][i][2] + v[rr][i][3];
    float mu[2], rstd[2];
#pragma unroll
    for (int rr = 0; rr < 2; ++rr) {
      mu[rr] = wave_sum(s[rr]) * (1.f / 2048.f);
      float q = 0.f;
#pragma unroll
      for (int i = 0; i < 8; ++i) { f32x4 d = v[rr][i] - mu[rr]; q += d[0] * d[0] + d[1] * d[1] + d[2] * d[2] + d[3] * d[3]; }
      rstd[rr] = rsqrtf(wave_sum(q) * (1.f / 2048.f) + EPS);
    }
#pragma unroll
    for (int i = 0; i < 8; ++i) {
      const int col = (i * 64 + lane) * 4;
      const f32x4 g = *(const f32x4*)(lng + col), bb = *(const f32x4*)(lnb + col);
      f32x4 sh = {0.f, 0.f, 0.f, 0.f}, sc = sh, shk = sh, sck = sh;
      if (modn) { sh = *(const f32x4*)(modn + (size_t)b * MODW + col); sc = *(const f32x4*)(modn + (size_t)b * MODW + 2048 + col); }
      if (modkv) { shk = *(const f32x4*)(modkv + (size_t)b * MODW + col); sck = *(const f32x4*)(modkv + (size_t)b * MODW + 2048 + col); }
#pragma unroll
      for (int rr = 0; rr < 2; ++rr) {
        const size_t off = (size_t)(row0 + rr) * D + col;
        f32x4 y = (v[rr][i] - mu[rr]) * rstd[rr] * g + bb;
        *(f32x4*)(xio + off) = y;
        if (modn) { f32x4 h = y * (1.f + sc) + sh; u32x2 o = {pack2(h[0], h[1]), pack2(h[2], h[3])}; *(u32x2*)(hout + off) = o; }
        if (modkv) { f32x4 h = y * (1.f + sck) + shk; u32x2 o = {pack2(h[0], h[1]), pack2(h[2], h[3])}; *(u32x2*)(hkout + off) = o; }
      }
    }
  }
}

DI void phase_fscan(const Params& p) {
  const float* zf = (const float*)(p.ws + WS_ZF);
  float* F = (float*)(p.ws + WS_FCUM);
  const int tid_ = tid_opq(), lane = tid_ & 63, wave = tid_ >> 6;
  for (int seq = bid_opq() * 8 + wave; seq < 256; seq += gridDim.x * 8) {
    const int b = seq >> 4, h = seq & 15;
    const float bf = p.kv_b_f[h];
    float run = 0.f, loc[32];
#pragma unroll
    for (int j = 0; j < 32; ++j) {
      float y = zf[((size_t)b * S + lane * 32 + j) * 16 + h] + bf;
      float ls = fminf(y, 0.f) - log1pf(__expf(-fabsf(y)));
      run += ls; loc[j] = run;
    }
    float incl = run;
#pragma unroll
    for (int o = 1; o < 64; o <<= 1) { float t = __shfl_up(incl, o); if (lane >= o) incl += t; }
    const float excl = incl - run;
    float* dst = F + (size_t)seq * S + lane * 32;
#pragma unroll
    for (int j = 0; j < 32; j += 4) { f32x4 o = {loc[j] + excl, loc[j + 1] + excl, loc[j + 2] + excl, loc[j + 3] + excl}; *(f32x4*)(dst + j) = o; }
  }
}

template <int KS> DI int lds_byte(int r, int c) {
  int st = (r >> 4) * KS + (c >> 5), ob = (r & 15) * 64 + (c & 31) * 2;
  return st * 1024 + (ob ^ (((ob >> 9) & 1) << 5));
}
template <int KS> DI void stage_rc(int b, int& R, int& C) {
  int st = b >> 10, sb = b & 1023, swz = sb ^ (((sb >> 9) & 1) << 5);
  R = (st / KS) * 16 + swz / 64;
  C = (st % KS) * 32 + (swz % 64) / 2;
}
#define WAIT_V(n) asm volatile("s_waitcnt vmcnt(%0)" ::"n"(n) : "memory")

struct EpiStore { u16* out; int ld; int ncut; float* zf; };
struct EpiResid { const float* xin; float* out; const float* gate;
                  const float* lng; const float* lnb; const float* modn; u16* hout; const float* modkv; u16* hkout;
                  float* stats; unsigned* cnt; unsigned target; };

DI void epi_store(const EpiStore& E, int row, int col, f32x4 v) {
  if (col < E.ncut) { u32x2 o = {pack2(v[0], v[1]), pack2(v[2], v[3])}; *(u32x2*)(E.out + (size_t)row * E.ld + col) = o; }
  else if (col < E.ncut + 16) { *(f32x4*)(E.zf + (size_t)row * 16 + (col - E.ncut)) = v; }
}
DI void gemm_epilogue(const EpiStore& E, f32x4 (&acc)[8][4], int brow, int bcol, int, int, int, int, int) {
  const int tid = tid_opq(), wid = tid >> 6, lane = tid & 63, wr = wid >> 2, wc = wid & 3, fr = lane & 15, fq = lane >> 4;
  if (bcol + 256 > E.ncut) {
#pragma unroll
    for (int m = 0; m < 8; ++m)
#pragma unroll
      for (int n = 0; n < 4; ++n) epi_store(E, brow + wr * 128 + m * 16 + fr, bcol + wc * 64 + n * 16 + fq * 4, acc[m][n]);
  } else {
    constexpr int EP = 528;
    LAS char* eb = (LAS char*)shm + 65536;
    LAS char* wp = eb + (wr * 64 + fr) * EP + (wc * 64 + fq * 4) * 2;
    LAS char* rp = eb + (tid >> 5) * EP + (tid & 31) * 16;
    u16* gp = E.out + (size_t)(brow + (tid >> 5)) * E.ld + bcol + (tid & 31) * 8;
    __syncthreads();
#pragma unroll
    for (int half = 0; half < 2; ++half) {
#pragma unroll
      for (int mm = 0; mm < 4; ++mm)
#pragma unroll
        for (int n = 0; n < 4; ++n) {
          const f32x4 v = acc[half * 4 + mm][n];
          u32x2 o = {pack2(v[0], v[1]), pack2(v[2], v[3])};
          *(LAS u32x2*)(wp + mm * 16 * EP + n * 32) = o;
        }
      __syncthreads();
#pragma unroll
      for (int i = 0; i < 8; ++i) {
        const u32x4 v = *(LAS u32x4*)(rp + i * 16 * EP);
        __builtin_nontemporal_store(v, (u32x4*)(gp + (size_t)((i >> 2) * 128 + (i & 3) * 16 + half * 64) * E.ld));

      }
      __syncthreads();
    }
  }
}

DI void gemm_epilogue(const EpiResid& E, f32x4 (&acc)[8][4], int brow, int bcol, int, int, int, int, int) {
  const int tid = tid_opq(), wid = tid >> 6, lane = tid & 63, wr = wid >> 2, wc = wid & 3, fr = lane & 15, fq = lane >> 4;
  LAS float* st_lds = (LAS float*)((LAS char*)shm + 131072);
  LAS float* mr_lds = (LAS float*)((LAS char*)shm + 131072 + 8192);
  const int b = brow >> 11, pm = brow >> 8, pn = bcol >> 8;
  const int col0 = bcol + wc * 64 + fq * 4;
  const float* gtp = E.gate + (size_t)b * MODW + col0;
  f32x4 xa[4], xb[4];
#pragma unroll
  for (int n = 0; n < 4; ++n) xa[n] = __builtin_nontemporal_load((const f32x4*)(E.xin + (size_t)(brow + wr * 128 + fr) * D + col0 + n * 16));
#pragma unroll
  for (int m = 0; m < 8; ++m) {
    asm volatile("" ::: "memory");
    if (m + 1 < 8) {
#pragma unroll
      for (int n = 0; n < 4; ++n) {
        const f32x4 t = __builtin_nontemporal_load((const f32x4*)(E.xin + (size_t)(brow + wr * 128 + (m + 1) * 16 + fr) * D + col0 + n * 16));
        if (m & 1) xa[n] = t; else xb[n] = t;
      }
    }
    asm volatile("" ::: "memory");
    float s1 = 0.f, s2 = 0.f;
#pragma unroll
    for (int n = 0; n < 4; ++n) {
      const f32x4 gtv = *(const f32x4*)(gtp + n * 16);
      f32x4 v = DN_ALPHA * ((m & 1) ? xb[n] : xa[n]) + gtv * acc[m][n];
      acc[m][n] = v;
      s1 += (v[0] + v[1]) + (v[2] + v[3]);
      s2 = __builtin_fmaf(v[0], v[0], s2); s2 = __builtin_fmaf(v[1], v[1], s2); s2 = __builtin_fmaf(v[2], v[2], s2); s2 = __builtin_fmaf(v[3], v[3], s2);
    }
    s1 += __shfl_xor(s1, 16); s2 += __shfl_xor(s2, 16);
    s1 += __shfl_xor(s1, 32); s2 += __shfl_xor(s2, 32);
    if (fq == 0) { const int lr = wr * 128 + m * 16 + fr; st_lds[(wc * 256 + lr) * 2] = s1; st_lds[(wc * 256 + lr) * 2 + 1] = s2; }
  }
  __syncthreads();
  if (tid < 256) {
    float s1 = 0.f, s2 = 0.f;
#pragma unroll
    for (int w = 0; w < 4; ++w) { s1 += st_lds[(w * 256 + tid) * 2]; s2 += st_lds[(w * 256 + tid) * 2 + 1]; }
    float* dst = E.stats + ((size_t)(pm * 8 + pn) * 256 + tid) * 2;
    __hip_atomic_store(dst, s1, __ATOMIC_RELAXED, __HIP_MEMORY_SCOPE_AGENT);
    __hip_atomic_store(dst + 1, s2, __ATOMIC_RELAXED, __HIP_MEMORY_SCOPE_AGENT);
  }
  asm volatile("s_waitcnt vmcnt(0) lgkmcnt(0)" ::: "memory");
  __syncthreads();
  if (tid == 0) {
    __hip_atomic_fetch_add(E.cnt + pm, 1u, __ATOMIC_RELAXED, __HIP_MEMORY_SCOPE_AGENT);
    unsigned spins = 0;
    while (__hip_atomic_load(E.cnt + pm, __ATOMIC_RELAXED, __HIP_MEMORY_SCOPE_AGENT) < E.target && ++spins < (1u << 24)) __builtin_amdgcn_s_sleep(1);
  }
  __syncthreads();
  if (tid < 256) {
    float s1 = 0.f, s2 = 0.f;
#pragma unroll
    for (int j = 0; j < 8; ++j) {
      const float* src = E.stats + ((size_t)(pm * 8 + j) * 256 + tid) * 2;
      s1 += __hip_atomic_load(src, __ATOMIC_RELAXED, __HIP_MEMORY_SCOPE_AGENT); s2 += __hip_atomic_load(src + 1, __ATOMIC_RELAXED, __HIP_MEMORY_SCOPE_AGENT);
    }
    const float mu = s1 * (1.f / 2048.f);
    const float var = fmaxf(s2 * (1.f / 2048.f) - mu * mu, 0.f);
    mr_lds[tid * 2] = mu; mr_lds[tid * 2 + 1] = rsqrtf(var + EPS);
  }
  __syncthreads();
#pragma unroll
  for (int n = 0; n < 4; ++n) {
    asm volatile("" ::: "memory");
    const int col = col0 + n * 16;
    const f32x4 g = *(const f32x4*)(E.lng + col), bb = *(const f32x4*)(E.lnb + col);
    f32x4 sh = {0.f, 0.f, 0.f, 0.f}, sc = sh, shk = sh, sck = sh;
    if (E.modn) { sh = *(const f32x4*)(E.modn + (size_t)b * MODW + col); sc = *(const f32x4*)(E.modn + (size_t)b * MODW + 2048 + col); }
    if (E.modkv) { shk = *(const f32x4*)(E.modkv + (size_t)b * MODW + col); sck = *(const f32x4*)(E.modkv + (size_t)b * MODW + 2048 + col); }
#pragma unroll
    for (int m = 0; m < 8; ++m) {
      const int lr = wr * 128 + m * 16 + fr;
      const float mu = mr_lds[lr * 2], rstd = mr_lds[lr * 2 + 1];
      const size_t off = (size_t)(brow + lr) * D + col;
      f32x4 y = (acc[m][n] - mu) * rstd * g + bb;
      __builtin_nontemporal_store(y, (f32x4*)(E.out + off));
      if (E.modn) { f32x4 hh = y * (1.f + sc) + sh; u32x2 o = {pack2(hh[0], hh[1]), pack2(hh[2], hh[3])}; *(u32x2*)(E.hout + off) = o; }
      if (E.modkv) { f32x4 hh = y * (1.f + sck) + shk; u32x2 o = {pack2(hh[0], hh[1]), pack2(hh[2], hh[3])}; *(u32x2*)(E.hkout + off) = o; }
    }
  }
}

DI void tile_coords(int t, int nN, int& pm, int& pn) {
  if (nN == 17) { if (t >= 2048) { pm = t - 2048; pn = 16; return; } nN = 16; }
  const int q = t >> 8, w = t & 255, x = w & 7, i = w >> 3;
  if (nN >= 16) { const int npn = nN >> 4; pm = (q / npn) * 16 + (x & 1) * 8 + (i & 7); pn = (q % npn) * 16 + (x >> 1) * 4 + (i >> 3); }
  else { pm = q * 32 + (x & 3) * 8 + (i & 7); pn = (x >> 2) * 4 + (i >> 3); }
}

template <class Epi>
DI void gemm_phase(const u16* A, const u16* Bt, int N, const Epi& E) {
  constexpr int K = 2048, BK = 64, KS = 2, TILE_B = 256 * BK * 2, GL = 4, STAGE_B = 2 * TILE_B, NT = K / BK;
  const int tid = tid_opq(), wid = tid >> 6, lane = tid & 63, wr = wid >> 2, wc = wid & 3, fr = lane & 15, fq = lane >> 4;
  unsigned soff[GL];
#pragma unroll
  for (int i = 0; i < GL; ++i) { int sR, sC; stage_rc<KS>(wid * 1024 + i * 8192 + lane * 16, sR, sC); soff[i] = (unsigned)((sR * K + sC) * 2); }
  const int nN = N >> 8, ntiles = 128 * nN;
#define SA(b) (shm + (b) * STAGE_B)
#define SB(b) (shm + (b) * STAGE_B + TILE_B)
#define GSRC(base, i, kt) ((const char*)((base) + (kt) * BK) + soff[i])
#define GLDS_STAGE(buf, kt, Ab_, Bb_) do { _Pragma("unroll") for (int i = 0; i < GL; ++i) { \
      __builtin_amdgcn_global_load_lds((const unsigned*)GSRC(Ab_, i, kt), (unsigned*)(SA(buf) + wid * 1024 + i * 8192), 16, 0, 0); \
      __builtin_amdgcn_global_load_lds((const unsigned*)GSRC(Bb_, i, kt), (unsigned*)(SB(buf) + wid * 1024 + i * 8192), 16, 0, 0); } } while (0)
  int t = bid_opq();
  if (t >= ntiles) return;
  int pm, pn;
  tile_coords(t, nN, pm, pn);
  const u16* Ab = A + (size_t)pm * 256 * K;
  const u16* Bb = Bt + (size_t)pn * 256 * K;
  GLDS_STAGE(0, 0, Ab, Bb); WAIT_V(0); __syncthreads();
  while (true) {
    const int brow = pm * 256, bcol = pn * 256;
    const int tn = t + gridDim.x;
    const u16* Abn = Ab; const u16* Bbn = Bb;
    if (tn < ntiles) { tile_coords(tn, nN, pm, pn); Abn = A + (size_t)pm * 256 * K; Bbn = Bt + (size_t)pn * 256 * K; }
    f32x4 acc[8][4];
#pragma unroll
    for (int m = 0; m < 8; ++m)
#pragma unroll
      for (int n = 0; n < 4; ++n) acc[m][n] = (f32x4){0.f, 0.f, 0.f, 0.f};
    for (int kt = 0; kt < NT; ++kt) {
      const int cur = kt & 1;
      if (kt + 1 < NT) GLDS_STAGE(cur ^ 1, kt + 1, Ab, Bb);
      else if (tn < ntiles) GLDS_STAGE(0, 0, Abn, Bbn);
#pragma unroll
      for (int ks = 0; ks < KS; ++ks) {
        bf16x8 At[8], Bf[4];
#pragma unroll
        for (int n = 0; n < 4; ++n) Bf[n] = *(const bf16x8*)(SB(cur) + lds_byte<KS>(wc * 64 + n * 16 + fr, ks * 32 + fq * 8));
#pragma unroll
        for (int m = 0; m < 8; ++m) At[m] = *(const bf16x8*)(SA(cur) + lds_byte<KS>(wr * 128 + m * 16 + fr, ks * 32 + fq * 8));
#pragma unroll
        for (int m = 0; m < 8; ++m)
#pragma unroll
          for (int n = 0; n < 4; ++n) acc[m][n] = __builtin_amdgcn_mfma_f32_16x16x32_bf16(Bf[n], At[m], acc[m][n], 0, 0, 0);
      }
      __builtin_amdgcn_sched_group_barrier(0x100, 8, 3);
#define SGB_M4R(nr) __builtin_amdgcn_sched_group_barrier(0x008, 4, 3); __builtin_amdgcn_sched_group_barrier(0x100, nr, 3);
      SGB_M4R(1) SGB_M4R(1) SGB_M4R(1) SGB_M4R(1) SGB_M4R(3) SGB_M4R(3)
      SGB_M4R(1) SGB_M4R(1) SGB_M4R(1) SGB_M4R(1) SGB_M4R(1) SGB_M4R(1)
      __builtin_amdgcn_sched_group_barrier(0x008, 16, 3);
#undef SGB_M4R
      __builtin_amdgcn_sched_barrier(0);
      if (kt + 1 < NT) { WAIT_V(0); __syncthreads(); }
    }
    gemm_epilogue(E, acc, brow, bcol, wr, wc, fr, fq, tid);
    WAIT_V(0); __syncthreads();
    if (tn >= ntiles) break;
    t = tn; Ab = Abn; Bb = Bbn;
  }
#undef SA
#undef SB
#undef GSRC
#undef GLDS_STAGE
}

template <bool DIFF, int NKB, int NDV, int KT, int KP, int VP>
DI void attn_tile(LAS char* sm, LAS char* Ks, LAS char* Vs, LAS char* cbs, int qoff, const bf16x8 (&qf_in)[8], f32x16 (&oacc)[NDV], float& mrow, float& lrow,
                  int k0, int t0, int tq0, int lane, int r, int h, int g, int qs, float scale2, float slope2) {
  bf16x8 qf[8];
#pragma unroll
  for (int ks = 0; ks < 8; ++ks) qf[ks] = qf_in[ks];
  f32x16 sacc[NKB];
#pragma unroll
  for (int kb = 0; kb < NKB; ++kb)
#pragma unroll
    for (int i = 0; i < 16; ++i) sacc[kb][i] = 0.f;
#pragma unroll
  for (int ks = 0; ks < 8; ++ks)
#pragma unroll
    for (int kb = 0; kb < NKB; ++kb) {
      bf16x8 a = *(LAS bf16x8*)(Ks + (kb * 32 + r) * KP + (g * 128 + ks * 16 + 8 * h) * 2);
      if (DIFF) qf[ks] = *(LAS bf16x8*)(sm + qoff + (qs * 32 + r) * KP + (g * 128 + ks * 16 + 8 * h) * 2);
      sacc[kb] = __builtin_amdgcn_mfma_f32_32x32x16_bf16(a, qf[ks], sacc[kb], 0, 0, 0);
    }
  {
    constexpr int RPM = DIFF ? 2 : 1, NM = 8 * NKB;
    __builtin_amdgcn_sched_group_barrier(0x100, 2 * RPM, 0);
#pragma unroll
    for (int jq = 0; jq < NM - 2; ++jq) { __builtin_amdgcn_sched_group_barrier(0x008, 1, 0); __builtin_amdgcn_sched_group_barrier(0x100, RPM, 0); }
    __builtin_amdgcn_sched_group_barrier(0x008, 2, 0);
  }
  float mx = -1e30f;
  const int dk = k0 + 4 * h - (tq0 + r);
  const float bias0 = DIFF ? slope2 * (float)(k0 + 4 * h - t0) : 0.f;
  if (k0 + KT - 1 > tq0) {
    asm volatile("" ::: "memory");
#pragma unroll
    for (int kb = 0; kb < NKB; ++kb)
#pragma unroll
      for (int a = 0; a < 4; ++a) {
        f32x4 cb4 = {0.f, 0.f, 0.f, 0.f};
        if (!DIFF) cb4 = *(LAS f32x4*)(cbs + (g * KT + kb * 32 + 8 * a + 4 * h) * 4);
#pragma unroll
        for (int jj = 0; jj < 4; ++jj) {
          const int off = kb * 32 + 8 * a + jj;
          float sv = __builtin_fmaf(sacc[kb][4 * a + jj], scale2, DIFF ? __builtin_fmaf((float)off, slope2, bias0) : cb4[jj]);
          if (dk + off > 0) sv = -1e30f;
          sacc[kb][4 * a + jj] = sv; mx = fmaxf(mx, sv);
        }
      }
  } else {
    asm volatile("" ::: "memory");
#pragma unroll
    for (int kb = 0; kb < NKB; ++kb)
#pragma unroll
      for (int a = 0; a < 4; ++a) {
        f32x4 cb4 = {0.f, 0.f, 0.f, 0.f};
        if (!DIFF) cb4 = *(LAS f32x4*)(cbs + (g * KT + kb * 32 + 8 * a + 4 * h) * 4);
#pragma unroll
        for (int jj = 0; jj < 4; ++jj) {
          const int off = kb * 32 + 8 * a + jj;
          float sv = __builtin_fmaf(sacc[kb][4 * a + jj], scale2, DIFF ? __builtin_fmaf((float)off, slope2, bias0) : cb4[jj]);
          sacc[kb][4 * a + jj] = sv; mx = fmaxf(mx, sv);
        }
      }
  }
  mx = xor32_max(mx);
  const float mnew = fmaxf(mrow, mx);
  const float alpha = __builtin_amdgcn_exp2f(mrow - mnew);
  mrow = mnew;
  float ps = 0.f;
#pragma unroll
  for (int kb = 0; kb < NKB; ++kb)
#pragma unroll
    for (int i = 0; i < 16; ++i) { float pv = __builtin_amdgcn_exp2f(sacc[kb][i] - mnew); sacc[kb][i] = pv; ps += pv; }
  lrow = lrow * alpha + ps;
  if (__any(alpha != 1.f)) {
#pragma unroll
    for (int d = 0; d < NDV; ++d)
#pragma unroll
      for (int i = 0; i < 16; ++i) oacc[d][i] *= alpha;
  }
  bf16x8 pf[NKB][2];
#pragma unroll
  for (int kb = 0; kb < NKB; ++kb)
#pragma unroll
    for (int s2 = 0; s2 < 2; ++s2) {
      u32x4 pk = {pack2(sacc[kb][8 * s2 + 0], sacc[kb][8 * s2 + 1]), pack2(sacc[kb][8 * s2 + 2], sacc[kb][8 * s2 + 3]),
                  pack2(sacc[kb][8 * s2 + 4], sacc[kb][8 * s2 + 5]), pack2(sacc[kb][8 * s2 + 6], sacc[kb][8 * s2 + 7])};
      pf[kb][s2] = __builtin_bit_cast(bf16x8, pk);
    }
  const int vrow = 4 * h + ((lane & 15) >> 2);
  const int vcol = (DIFF ? 0 : g * 128) + 16 * ((lane >> 4) & 1) + 4 * (lane & 3);
#pragma unroll
  for (int d = 0; d < NDV; ++d)
#pragma unroll
    for (int kb = 0; kb < NKB; ++kb)
#pragma unroll
      for (int s2 = 0; s2 < 2; ++s2) {
        LAS char* vp = Vs + (kb * 32 + 16 * s2 + vrow) * VP + (vcol + d * 32) * 2;
        s16x4 lo = __builtin_amdgcn_ds_read_tr16_b64_v4i16((LAS s16x4*)vp);
        s16x4 hi = __builtin_amdgcn_ds_read_tr16_b64_v4i16((LAS s16x4*)(vp + 8 * VP));
        bf16x8 a = __builtin_shufflevector(lo, hi, 0, 1, 2, 3, 4, 5, 6, 7);
        oacc[d] = __builtin_amdgcn_mfma_f32_32x32x16_bf16(a, pf[kb][s2], oacc[d], 0, 0, 0);
      }
  {
    constexpr int NM = NDV * NKB * 2;
    __builtin_amdgcn_sched_group_barrier(0x100, 4, 1);
#pragma unroll
    for (int jq = 0; jq < NM - 2; ++jq) { __builtin_amdgcn_sched_group_barrier(0x008, 1, 1); __builtin_amdgcn_sched_group_barrier(0x100, 2, 1); }
    __builtin_amdgcn_sched_group_barrier(0x008, 2, 1);
  }
}

template <bool DIFF>
DI void attn_phase(const u16* Qb, int ldq, const u16* Kb, int ldk, const u16* Vb, int ldv, const u16* Gb, int ldg,
                   u16* Ob, const float* Fcum, float lam, float outscale, const float* subln) {
  constexpr int KT = DIFF ? 32 : 64, NKB = KT / 32, NDV = DIFF ? 8 : 4;
  constexpr int KP = 528, VP = 576, STAGE = KT * (KP + VP), NLD = KT * 32 / 512, CB_OFF = 2 * STAGE, QOFF = 2 * STAGE;
  const float scale2 = 0.08838834764831845f * LOG2E;
  LAS char* sm = (LAS char*)shm;

  for (int j = bid_opq(); j < 2048; j += gridDim.x) {
    const int tid = tid_opq(), lane = tid & 63, wave = __builtin_amdgcn_readfirstlane(tid >> 6);
    const int r = lane & 31, h = lane >> 5, g = wave >> 2, qs = wave & 3;
    const int bid = j & 255, rr = j >> 8, hp = bid & 7, ii = bid >> 3;
    const int b = 2 * rr + (ii >> 4), qb = (rr & 1) ? 15 - (ii & 15) : (ii & 15);
    const int t0 = qb * 128, tq0 = t0 + qs * 32, ntile = (t0 + 128) / KT;
    const size_t rowbase = (size_t)b * S;

    bf16x8 qf[8];
    if (DIFF) {
#pragma unroll
      for (int i = 0; i < 8; ++i) {
        const int idx = tid + i * 512, row = idx >> 5, ch = idx & 31;
        *(LAS i32x4*)(sm + QOFF + row * KP + ch * 16) = *(const i32x4*)(Qb + (rowbase + t0 + row) * ldq + hp * 256 + ch * 8);
      }
#pragma unroll
      for (int ks = 0; ks < 8; ++ks) qf[ks] = (bf16x8){0, 0, 0, 0, 0, 0, 0, 0};
    } else {
      const u16* qp = Qb + (rowbase + tq0 + r) * ldq + hp * 256 + g * 128 + 8 * h;
#pragma unroll
      for (int ks = 0; ks < 8; ++ks) qf[ks] = *(const bf16x8*)(qp + ks * 16);
    }
    f32x16 oacc[NDV];
#pragma unroll
    for (int d = 0; d < NDV; ++d)
#pragma unroll
      for (int i = 0; i < 16; ++i) oacc[d][i] = 0.f;
    float mrow = -1e30f, lrow = 0.f;
    const float slope2 = DIFF ? exp2f(-(float)(hp + 1)) * LOG2E : 0.f;
    const float* Fp = nullptr; float Ft0 = 0.f;
    if (!DIFF && tid < 2 * KT) { Fp = Fcum + ((size_t)(b * 16 + 2 * hp + tid / KT)) * S; Ft0 = Fp[t0]; }

    const unsigned koff = (unsigned)(((tid >> 5) * ldk + (tid & 31) * 8) * 2), voff = (unsigned)(((tid >> 5) * ldv + (tid & 31) * 8) * 2);
#define AT_ISSUE(KR, VR, CR, kt) do { const int k0_ = (kt) * KT; \
      const char* kbase_ = (const char*)(Kb + (rowbase + k0_) * ldk + hp * 256); \
      const char* vbase_ = (const char*)(Vb + (rowbase + k0_) * ldv + hp * 256); \
      _Pragma("unroll") for (int i = 0; i < NLD; ++i) { \
      KR[i] = *(const i32x4*)(kbase_ + (size_t)i * 16 * ldk * 2 + koff); \
      VR[i] = *(const i32x4*)(vbase_ + (size_t)i * 16 * ldv * 2 + voff); } \
      if (!DIFF && tid < 2 * KT) CR = (Ft0 - Fp[k0_ + (tid % KT)]) * LOG2E; } while (0)
#define AT_WRITE(KR, VR, CR, st) do { _Pragma("unroll") for (int i = 0; i < NLD; ++i) { \
      const int idx = tid + i * 512, row = idx >> 5, ch = idx & 31; \
      *(LAS i32x4*)(sm + (st) * STAGE + row * KP + ch * 16) = KR[i]; \
      *(LAS i32x4*)(sm + (st) * STAGE + KT * KP + row * VP + ch * 16) = VR[i]; } \
      if (!DIFF && tid < 2 * KT) *(LAS float*)(sm + CB_OFF + ((st) * 2 * KT + tid) * 4) = CR; } while (0)
#define AT_COMPUTE(it_, st) do { const int k0c_ = (ntile - 1 - (it_)) * KT; if (k0c_ <= tq0 + 31) \
      attn_tile<DIFF, NKB, NDV, KT, KP, VP>(sm, sm + (st) * STAGE, sm + (st) * STAGE + KT * KP, sm + CB_OFF + (st) * 2 * KT * 4, QOFF, qf, oacc, mrow, lrow, \
                                             k0c_, t0, tq0, lane, r, h, g, qs, scale2, slope2); } while (0)
    i32x4 kregA[NLD], vregA[NLD]; float cbregA = 0.f;
    {
      i32x4 kregB[NLD], vregB[NLD]; float cbregB = 0.f;
      AT_ISSUE(kregA, vregA, cbregA, ntile - 1); AT_WRITE(kregA, vregA, cbregA, 0);
      AT_ISSUE(kregA, vregA, cbregA, max(ntile - 2, 0));
      AT_ISSUE(kregB, vregB, cbregB, max(ntile - 3, 0));
      __syncthreads();
      for (int it = 0; it < ntile; it += 2) {
        AT_COMPUTE(it, 0);
        AT_WRITE(kregA, vregA, cbregA, 1);
        AT_ISSUE(kregA, vregA, cbregA, max(ntile - 4 - it, 0));
        __syncthreads();
        AT_COMPUTE(it + 1, 1);
        AT_WRITE(kregB, vregB, cbregB, 0);
        AT_ISSUE(kregB, vregB, cbregB, max(ntile - 5 - it, 0));
        __syncthreads();
      }
    }
#undef AT_ISSUE
#undef AT_WRITE
#undef AT_COMPUTE
    int lo_ = lane; asm volatile("" : "+v"(lo_));
    const int h_ = lo_ >> 5, r_ = lo_ & 31;
    const float ltot = lrow + __shfl_xor(lrow, 32);
    const float inv = 1.f / ltot;
    const size_t orow = rowbase + tq0 + r_;
    const int cbase = hp * 256 + (DIFF ? 0 : g * 128) + 4 * h_;
    const u16* gptr = Gb + orow * ldg + cbase;
    u16* optr = Ob + orow * D + cbase;
    if (!DIFF) {
#pragma unroll
      for (int d = 0; d < NDV; ++d)
#pragma unroll
        for (int a = 0; a < 4; ++a) {
          u32x2 gz = *(const u32x2*)(gptr + d * 32 + 8 * a);
          float o0 = oacc[d][4 * a + 0] * inv * silu_f(bf_lo(gz[0]));
          float o1 = oacc[d][4 * a + 1] * inv * silu_f(bf_hi(gz[0]));
          float o2 = oacc[d][4 * a + 2] * inv * silu_f(bf_lo(gz[1]));
          float o3 = oacc[d][4 * a + 3] * inv * silu_f(bf_hi(gz[1]));
          u32x2 o = {pack2(o0, o1), pack2(o2, o3)};
          *(u32x2*)(optr + d * 32 + 8 * a) = o;
        }
    } else {
      constexpr int IP = 1040;
      LAS char* img = sm + (qs * 32 + r_) * IP + 16 * h_;
      LAS float* rnorm = (LAS float*)(sm + 128 * IP);
      if (g == 1) {
        const float sc = lam * inv;
#pragma unroll
        for (int d = 0; d < NDV; ++d)
#pragma unroll
          for (int a = 0; a < 4; ++a) {
            f32x4 v = {oacc[d][4 * a] * sc, oacc[d][4 * a + 1] * sc, oacc[d][4 * a + 2] * sc, oacc[d][4 * a + 3] * sc};
            *(LAS f32x4*)(img + (d * 32 + 8 * a) * 4) = v;
          }
      }
      __syncthreads();
      if (g == 0) {
        float ss = 0.f;
#pragma unroll
        for (int d = 0; d < NDV; ++d)
#pragma unroll
          for (int a = 0; a < 4; ++a) {
            LAS f32x4* pp = (LAS f32x4*)(img + (d * 32 + 8 * a) * 4);
            const f32x4 x4 = *pp;
            f32x4 dv;
#pragma unroll
            for (int jj = 0; jj < 4; ++jj) { dv[jj] = oacc[d][4 * a + jj] * inv - x4[jj]; ss = __builtin_fmaf(dv[jj], dv[jj], ss); }
            *pp = dv;
          }
        ss += __shfl_xor(ss, 32);
        if (h_ == 0) rnorm[qs * 32 + r_] = rsqrtf(ss * (1.f / 256.f) + EPS) * outscale;
      }
      __syncthreads();
      {
        int t2 = tid; asm volatile("" : "+v"(t2));
        const int c8 = t2 & 31, rg = t2 >> 5;
        const f32x4 sg0 = *(const f32x4*)(subln + c8 * 8), sg1 = *(const f32x4*)(subln + c8 * 8 + 4);
        const u16* gp2 = Gb + (rowbase + t0 + rg) * ldg + hp * 256 + c8 * 8;
        u16* op2 = Ob + (rowbase + t0 + rg) * D + hp * 256 + c8 * 8;
        LAS char* ip2 = sm + rg * IP + c8 * 32;
#pragma unroll
        for (int i = 0; i < 8; ++i) {
          const u32x4 gz = *(const u32x4*)(gp2 + (size_t)i * 16 * ldg);
          const f32x4 d0 = *(LAS f32x4*)(ip2 + i * 16 * IP), d1 = *(LAS f32x4*)(ip2 + i * 16 * IP + 16);
          const float rn = rnorm[rg + 16 * i];
          u32x4 o;
          o[0] = pack2(d0[0] * rn * sg0[0] * silu_f(bf_lo(gz[0])), d0[1] * rn * sg0[1] * silu_f(bf_hi(gz[0])));
          o[1] = pack2(d0[2] * rn * sg0[2] * silu_f(bf_lo(gz[1])), d0[3] * rn * sg0[3] * silu_f(bf_hi(gz[1])));
          o[2] = pack2(d1[0] * rn * sg1[0] * silu_f(bf_lo(gz[2])), d1[1] * rn * sg1[1] * silu_f(bf_hi(gz[2])));
          o[3] = pack2(d1[2] * rn * sg1[2] * silu_f(bf_lo(gz[3])), d1[3] * rn * sg1[3] * silu_f(bf_hi(gz[3])));
          *(u32x4*)(op2 + (size_t)i * 16 * D) = o;
        }
      }
      __syncthreads();
    }
  }
}

DI void attn_fox_phase(const u16* Qb, int ldq, const u16* Kb, int ldk, const u16* Vb, int ldv, const u16* Gb, int ldg, u16* Ob, const float* Fcum) {
  constexpr int KT = 64, NKB = 2, NDV = 4, KP = 272, VP = 320, STAGE = KT * (KP + VP), CB_OFF = 2 * STAGE, NLD = 2;
  const float scale2 = 0.08838834764831845f * LOG2E;
  LAS char* sm = (LAS char*)shm;
  for (int j = bid_opq(); j < 2048; j += gridDim.x) {
    const int tid = tid_opq(), lane = tid & 63, wave = __builtin_amdgcn_readfirstlane(tid >> 6);
    const int r = lane & 31, h = lane >> 5, qs = wave;
    const int bid = j & 255, rr = j >> 8, xx = bid & 7, ii = bid >> 3;
    const int head = xx + 8 * ((ii >> 3) & 1), b = 2 * rr + (ii >> 4), qb = (rr & 1) ? 7 - (ii & 7) : (ii & 7);
    const int t0 = qb * 256, tq0 = t0 + qs * 32, ntile = (t0 + 256) / KT;
    const size_t rowbase = (size_t)b * S;
    bf16x8 qf[8];
    {
      const u16* qp = Qb + (rowbase + tq0 + r) * ldq + head * 128 + 8 * h;
#pragma unroll
      for (int ks = 0; ks < 8; ++ks) qf[ks] = *(const bf16x8*)(qp + ks * 16);
    }
    f32x16 oacc[NDV];
#pragma unroll
    for (int d = 0; d < NDV; ++d)
#pragma unroll
      for (int i = 0; i < 16; ++i) oacc[d][i] = 0.f;
    float mrow = -1e30f, lrow = 0.f;
    const float* Fp = Fcum + ((size_t)(b * 16 + head)) * S + (tid & 63);
    const float Ft0 = Fp[t0 - (tid & 63)];
    const unsigned koff = (unsigned)(((tid >> 4) * ldk + (tid & 15) * 8) * 2), voff = (unsigned)(((tid >> 4) * ldv + (tid & 15) * 8) * 2);
#define FX_ISSUE(KR, VR, CR, kt) do { const int k0_ = (kt) * KT; \
      const char* kbase_ = (const char*)(Kb + (rowbase + k0_) * ldk + head * 128); \
      const char* vbase_ = (const char*)(Vb + (rowbase + k0_) * ldv + head * 128); \
      _Pragma("unroll") for (int i = 0; i < NLD; ++i) { \
      KR[i] = *(const i32x4*)(kbase_ + (size_t)i * 32 * ldk * 2 + koff); \
      VR[i] = *(const i32x4*)(vbase_ + (size_t)i * 32 * ldv * 2 + voff); } \
      CR = (Ft0 - Fp[k0_]) * LOG2E; } while (0)
#define FX_WRITE(KR, VR, CR, st) do { _Pragma("unroll") for (int i = 0; i < NLD; ++i) { \
      const int idx = tid + i * 512, row = idx >> 4, ch = idx & 15; \
      *(LAS i32x4*)(sm + (st) * STAGE + row * KP + ch * 16) = KR[i]; \
      *(LAS i32x4*)(sm + (st) * STAGE + KT * KP + row * VP + ch * 16) = VR[i]; } \
      if (tid < KT) *(LAS float*)(sm + CB_OFF + ((st) * KT + tid) * 4) = CR; } while (0)
#define FX_COMPUTE(it_, st) do { const int k0c_ = (ntile - 1 - (it_)) * KT; if (k0c_ <= tq0 + 31) \
      attn_tile<false, NKB, NDV, KT, KP, VP>(sm, sm + (st) * STAGE, sm + (st) * STAGE + KT * KP, sm + CB_OFF + (st) * KT * 4, 0, qf, oacc, mrow, lrow, \
                                              k0c_, t0, tq0, lane, r, h, 0, qs, scale2, 0.f); } while (0)
    i32x4 kregA[NLD], vregA[NLD], kregB[NLD], vregB[NLD]; float cbregA = 0.f, cbregB = 0.f;
    FX_ISSUE(kregA, vregA, cbregA, ntile - 1); FX_WRITE(kregA, vregA, cbregA, 0);
    FX_ISSUE(kregA, vregA, cbregA, max(ntile - 2, 0));
    FX_ISSUE(kregB, vregB, cbregB, max(ntile - 3, 0));
    __syncthreads();
    for (int it = 0; it < ntile; it += 2) {
      FX_COMPUTE(it, 0);
      FX_WRITE(kregA, vregA, cbregA, 1);
      FX_ISSUE(kregA, vregA, cbregA, max(ntile - 4 - it, 0));
      __syncthreads();
      FX_COMPUTE(it + 1, 1);
      FX_WRITE(kregB, vregB, cbregB, 0);
      FX_ISSUE(kregB, vregB, cbregB, max(ntile - 5 - it, 0));
      __syncthreads();
    }
#undef FX_ISSUE
#undef FX_WRITE
#undef FX_COMPUTE
    int lo_ = lane; asm volatile("" : "+v"(lo_));
    const int h_ = lo_ >> 5, r_ = lo_ & 31;
    const float ltot = lrow + __shfl_xor(lrow, 32);
    const float inv = 1.f / ltot;
    constexpr int IP = 528;
    {
      LAS char* img = sm + (qs * 32 + r_) * IP + 16 * h_;
#pragma unroll
      for (int d = 0; d < NDV; ++d)
#pragma unroll
        for (int a = 0; a < 4; ++a) {
          f32x4 v = {oacc[d][4 * a] * inv, oacc[d][4 * a + 1] * inv, oacc[d][4 * a + 2] * inv, oacc[d][4 * a + 3] * inv};
          *(LAS f32x4*)(img + (d * 32 + 8 * a) * 4) = v;
        }
    }
    __syncthreads();
    {
      int t2 = tid; asm volatile("" : "+v"(t2));
      const int c8 = t2 & 15, rg = t2 >> 4;
      const u16* gp2 = Gb + (rowbase + t0 + rg) * ldg + head * 128 + c8 * 8;
      u16* op2 = Ob + (rowbase + t0 + rg) * D + head * 128 + c8 * 8;
      LAS char* ip2 = sm + rg * IP + c8 * 32;
#pragma unroll
      for (int i = 0; i < 8; ++i) {
        const u32x4 gz = *(const u32x4*)(gp2 + (size_t)i * 32 * ldg);
        const f32x4 d0 = *(LAS f32x4*)(ip2 + i * 32 * IP), d1 = *(LAS f32x4*)(ip2 + i * 32 * IP + 16);
        u32x4 o;
        o[0] = pack2(d0[0] * silu_f(bf_lo(gz[0])), d0[1] * silu_f(bf_hi(gz[0])));
        o[1] = pack2(d0[2] * silu_f(bf_lo(gz[1])), d0[3] * silu_f(bf_hi(gz[1])));
        o[2] = pack2(d1[0] * silu_f(bf_lo(gz[2])), d1[1] * silu_f(bf_hi(gz[2])));
        o[3] = pack2(d1[2] * silu_f(bf_lo(gz[3])), d1[3] * silu_f(bf_hi(gz[3])));
        *(u32x4*)(op2 + (size_t)i * 32 * D) = o;
      }
    }
    __syncthreads();
  }
}

DI void grid_bar(unsigned* ctr, unsigned target) {
  asm volatile("s_waitcnt vmcnt(0) lgkmcnt(0)" ::: "memory");
  __syncthreads();
  if (threadIdx.x == 0) {
    __builtin_amdgcn_fence(__ATOMIC_RELEASE, "agent");
    asm volatile("s_waitcnt vmcnt(0)" ::: "memory");
    __hip_atomic_fetch_add(ctr, 1u, __ATOMIC_RELAXED, __HIP_MEMORY_SCOPE_AGENT);
    unsigned spins = 0;
    while (__hip_atomic_load(ctr, __ATOMIC_RELAXED, __HIP_MEMORY_SCOPE_AGENT) < target && ++spins < (1u << 24)) __builtin_amdgcn_s_sleep(2);
    __builtin_amdgcn_fence(__ATOMIC_ACQUIRE, "agent");
    asm volatile("s_waitcnt vmcnt(0)" ::: "memory");
  }
  __syncthreads();
}

__global__ void __launch_bounds__(512, 2) mk_fwd(Params p_arg) {
  cg::grid_group grid = cg::this_grid();
  typedef __attribute__((address_space(4))) const Params* KP;
  KP kp0 = (KP)__builtin_amdgcn_kernarg_segment_ptr();
  Params p;
  p.ws = kp0->ws; p.ph_lo = kp0->ph_lo; p.ph_hi = kp0->ph_hi;
  char* ws = p.ws;
  float* modf = (float*)(ws + WS_MODF);
  u16* hb = (u16*)(ws + WS_H);
  u16* proj = (u16*)(ws + WS_PROJ);
  u16* kvb = proj + (size_t)M * 4096;
  unsigned* bar = (unsigned*)(ws + WS_BAR);
  if (blockIdx.x == 0 && threadIdx.x < 256) __hip_atomic_store(bar + threadIdx.x, 0u, __ATOMIC_RELAXED, __HIP_MEMORY_SCOPE_AGENT);
  unsigned nbar = 0;
  for (int ph = p.ph_lo; ph < p.ph_hi; ++ph) {
    if (ph == p.ph_lo + 1) grid.sync();
    else if (ph > p.ph_lo + 1) { ++nbar; grid_bar(bar, nbar * gridDim.x); }
    { KP q_ = kp0; asm volatile("" : "+s"(q_)); const int lo_ = p.ph_lo, hi_ = p.ph_hi; p = *(const Params*)q_; p.ph_lo = lo_; p.ph_hi = hi_; }
    if (ph == 0) phase0(p);
    else if (ph == 1) phase_modfin(p);
    else if (ph == 2) phase_modulate0(p);
    else if (ph == 9) {
      EpiStore E{kvb, 4096, 4096, (float*)(ws + WS_ZF)};
      gemm_phase(proj  , (const u16*)(ws + WS_WT_KV), 4352, E);
    } else {
      const bool isA = ph < 9;
      const int q = isA ? ph - 3 : ph - 10, li = q / 3, sub = q % 3, l = isA ? li : 2 + li;
      if (sub == 0) {
        if (l == 2) { phase_fscan(p); }
        const u16* Bt = isA ? (const u16*)(ws + WS_WT_AIN) + (size_t)li * 8192 * 2048 : (const u16*)(ws + WS_WT_BIN) + (size_t)li * 4096 * 2048;
        const int N = isA ? 8192 : 4096;
        EpiStore E{proj, N, N, nullptr};
        gemm_phase(hb, Bt, N, E);
      } else if (sub == 1) {
        if (isA) {
          const int lane = tid_opq() & 63;
          float s1 = p.lq1[l * 128 + lane] * p.lk1[l * 128 + lane] + p.lq1[l * 128 + 64 + lane] * p.lk1[l * 128 + 64 + lane];
          float s2 = p.lq2[l * 128 + lane] * p.lk2[l * 128 + lane] + p.lq2[l * 128 + 64 + lane] * p.lk2[l * 128 + 64 + lane];
          s1 = wave_sum(s1); s2 = wave_sum(s2);
          const float lam_init = 0.8f - 0.6f * expf(-0.3f * (float)l);
          const float lam = expf(s1) - expf(s2) + lam_init;
          attn_phase<true>(proj, 8192, proj + 2048, 8192, proj + 4096, 8192, proj + 6144, 8192, hb, nullptr, lam, 1.f - lam_init, p.subln + l * 256);
        } else {
          attn_fox_phase(proj, 4096, kvb, 4096, kvb + 2048, 4096, proj + 2048, 4096, hb, (const float*)(ws + WS_FCUM));
        }
      } else {
        const u16* Bt = isA ? (const u16*)(ws + WS_WT_AOUT) + (size_t)li * 2048 * 2048 : (const u16*)(ws + WS_WT_BOUT) + (size_t)li * 2048 * 2048;
        EpiResid E{l == 0 ? p.x : p.out, p.out, modf + l * 6144 + 4096, p.ln_g + l * 2048, p.ln_b + l * 2048,
                   l < 3 ? modf + (l + 1) * 6144 : nullptr, hb, l == 1 ? modf + 24576 : nullptr, proj,
                   (float*)(ws + WS_STATS), bar + 64, 8u * (unsigned)(l + 1)};
        gemm_phase(hb, Bt, 2048, E);
      }
    }
  }
}

extern "C" void kernel_launch(void* const* d_in, const int* in_sizes, int n_in, void* d_out, int out_size, void* d_ws, size_t ws_size,
                              hipStream_t stream) {
  static int grid = 0;
  if (grid == 0) {
    if (ws_size < WS_END) { fprintf(stderr, "kernel_launch: workspace too small: %zu < %zu\n", ws_size, (size_t)WS_END); grid = -1; return; }
    int dev = 0, cus = 0, per_cu = 0;
    hipGetDevice(&dev);
    hipDeviceGetAttribute(&cus, hipDeviceAttributeMultiprocessorCount, dev);
    if (hipFuncSetAttribute((const void*)mk_fwd, hipFuncAttributeMaxDynamicSharedMemorySize, LDS_BYTES) != hipSuccess) { fprintf(stderr, "kernel_launch: hipFuncSetAttribute failed\n"); grid = -1; return; }
    if (hipOccupancyMaxActiveBlocksPerMultiprocessor(&per_cu, (const void*)mk_fwd, 512, LDS_BYTES) != hipSuccess || per_cu < 1) per_cu = 1;
    (void)hipGetLastError();
    grid = cus * per_cu;
    fprintf(stderr, "kernel_launch: cus %d per_cu %d grid %d\n", cus, per_cu, grid);
  }
  if (grid < 0) return;
  Params p{};
  p.x = (const float*)d_in[0]; p.c = (const float*)d_in[1]; p.w_mod = (const float*)d_in[2]; p.b_mod = (const float*)d_in[3];
  p.ln_g = (const float*)d_in[4]; p.ln_b = (const float*)d_in[5]; p.a_w_in = (const float*)d_in[6]; p.a_w_out = (const float*)d_in[7];
  p.lq1 = (const float*)d_in[8]; p.lk1 = (const float*)d_in[9]; p.lq2 = (const float*)d_in[10]; p.lk2 = (const float*)d_in[11];
  p.subln = (const float*)d_in[12]; p.kv_w_mod = (const float*)d_in[13]; p.kv_b_mod = (const float*)d_in[14]; p.kv_w = (const float*)d_in[15];
  p.kv_b_f = (const float*)d_in[16]; p.b_w_in = (const float*)d_in[17]; p.b_w_out = (const float*)d_in[18];
  p.out = (float*)d_out; p.ws = (char*)d_ws;
  p.ph_lo = 0; p.ph_hi = NPHASE;
  void* args[] = {&p};
  hipError_t e = hipLaunchCooperativeKernel((void*)mk_fwd, dim3(grid), dim3(512), args, LDS_BYTES, stream);
  if (e != hipSuccess) fprintf(stderr, "cooperative launch failed: %s (grid %d)\n", hipGetErrorString(e), grid);
}
```

```cpp
#include <hip/hip_runtime.h>
#include <hip/hip_cooperative_groups.h>
#include <cstdio>
namespace cg = cooperative_groups;

#ifndef MK_MULTI
#define MK_MULTI 0
#endif

typedef unsigned short u16;
using bf16x8 = __attribute__((ext_vector_type(8))) short;
using s16x4  = __attribute__((ext_vector_type(4))) short;
using f32x4  = __attribute__((ext_vector_type(4))) float;
using f32x16 = __attribute__((ext_vector_type(16))) float;
using i32x4  = __attribute__((ext_vector_type(4))) int;
using u32x2  = __attribute__((ext_vector_type(2))) unsigned;
using u32x4  = __attribute__((ext_vector_type(4))) unsigned;
typedef __attribute__((ext_vector_type(2))) __bf16 bf2_t;
typedef __attribute__((ext_vector_type(2))) float f2_t;
#define LAS __attribute__((address_space(3)))
#define DI __device__ __forceinline__
#ifndef REP_A
#define REP_A 1
#endif
#ifndef REP_B
#define REP_B 1
#endif
#ifndef REP_G
#define REP_G 1
#endif

constexpr int D = 2048, NBATCH = 16, S = 2048, M = NBATCH * S;
constexpr int MODW = 28672;
constexpr int KSPLIT = 16;
constexpr float LOG2E = 1.4426950408889634f;
constexpr float DN_ALPHA = 1.681792830507429f;
constexpr float EPS = 1e-5f;

constexpr size_t WS_WT_AIN  = 0;
constexpr size_t WS_WT_AOUT = WS_WT_AIN  + (size_t)2 * 8192 * 2048 * 2;
constexpr size_t WS_WT_KV   = WS_WT_AOUT + (size_t)2 * 2048 * 2048 * 2;
constexpr size_t WS_WT_BIN  = WS_WT_KV   + (size_t)4352 * 2048 * 2;
constexpr size_t WS_WT_BOUT = WS_WT_BIN  + (size_t)2 * 4096 * 2048 * 2;
constexpr size_t WS_PART    = WS_WT_BOUT + (size_t)2 * 2048 * 2048 * 2;
constexpr size_t WS_MODF    = WS_PART    + (size_t)KSPLIT * 16 * MODW * 4;
constexpr size_t WS_ZF      = WS_MODF    + (size_t)16 * MODW * 4;
constexpr size_t WS_FCUM    = WS_ZF      + (size_t)M * 16 * 4;
constexpr size_t WS_H       = WS_FCUM    + (size_t)M * 16 * 4;
constexpr size_t WS_PROJ    = WS_H       + (size_t)M * 2048 * 2;
constexpr size_t WS_BAR     = WS_PROJ    + (size_t)M * 8192 * 2;
constexpr size_t WS_STATS   = WS_BAR     + 4096;
constexpr size_t WS_END     = WS_STATS   + (size_t)128 * 8 * 256 * 8;

constexpr int LDS_BYTES = 2 * 64 * (528 + 576) + 2 * 2 * 64 * 4;
constexpr int NPHASE = 16;

struct Params {
  const float *x, *c, *w_mod, *b_mod, *ln_g, *ln_b, *a_w_in, *a_w_out, *lq1, *lk1, *lq2, *lk2, *subln,
              *kv_w_mod, *kv_b_mod, *kv_w, *kv_b_f, *b_w_in, *b_w_out;
  float* out; char* ws; int ph_lo, ph_hi;
};

extern __shared__ __attribute__((aligned(1024))) char shm[];

DI unsigned pack2(float a, float b) { f2_t v = {a, b}; bf2_t r = __builtin_convertvector(v, bf2_t); return __builtin_bit_cast(unsigned, r); }
DI float bf_lo(unsigned u) { return __uint_as_float(u << 16); }
DI float bf_hi(unsigned u) { return __uint_as_float(u & 0xffff0000u); }
DI float silu_f(float x) { return x / (1.f + __expf(-x)); }
DI int tid_opq() { int t = threadIdx.x; asm volatile("" : "+v"(t)); return t; }
DI int bid_opq() { int b = blockIdx.x; asm volatile("" : "+s"(b)); return b; }
DI float xor32_max(float x) {
  auto r = __builtin_amdgcn_permlane32_swap(__float_as_uint(x), __float_as_uint(x), false, false);
  return fmaxf(__uint_as_float(r[0]), __uint_as_float(r[1]));
}
DI float wave_sum(float v) {
#pragma unroll
  for (int o = 32; o >= 1; o >>= 1) v += __shfl_xor(v, o);
  return v;
}

DI void convert_tile(const float* __restrict__ W, int N, u16* __restrict__ Wt, int tk, int tn) {
  float* tile = (float*)shm;
  const int tid = tid_opq(), k0 = tk * 64, n0 = tn * 64;
#pragma unroll
  for (int i = 0; i < 2; ++i) {
    int kk = (tid >> 4) + 32 * i, c4 = (tid & 15) * 4, n = n0 + c4;
    f32x4 v = {0.f, 0.f, 0.f, 0.f};
    if (n < N) v = __builtin_nontemporal_load((const f32x4*)(W + (size_t)(k0 + kk) * N + n));
    tile[kk * 65 + c4 + 0] = v[0]; tile[kk * 65 + c4 + 1] = v[1]; tile[kk * 65 + c4 + 2] = v[2]; tile[kk * 65 + c4 + 3] = v[3];
  }
  __syncthreads();
  {
    int n = tid >> 3, ks = tid & 7;
    float f[8];
#pragma unroll
    for (int j = 0; j < 8; ++j) f[j] = tile[(ks * 8 + j) * 65 + n];
    u32x4 o = {pack2(f[0], f[1]), pack2(f[2], f[3]), pack2(f[4], f[5]), pack2(f[6], f[7])};
    *(u32x4*)(Wt + (size_t)(n0 + n) * 2048 + k0 + ks * 8) = o;
  }
  __syncthreads();
}

DI void mod_task(const Params& p, int task) {
  float* cact = (float*)shm;
  float* part = (float*)(p.ws + WS_PART);
  const int tid = tid_opq();
  const int ks = task / 14, cgp = task % 14, k0 = ks * 128;
  const int c = (cgp * 512 + tid) * 4;
  const float* W; int N, lc;
  if (c < 24576) { int set = c / 6144; W = p.w_mod + (size_t)set * 2048 * 6144; N = 6144; lc = c - set * 6144; }
  else { W = p.kv_w_mod; N = 4096; lc = c - 24576; }
  for (int idx = tid; idx < 128 * 16; idx += 512) {
    int kk = idx & 127, b = idx >> 7;
    float v = p.c[b * 2048 + k0 + kk];
    cact[kk * 16 + b] = silu_f(v);
  }
  __syncthreads();
  f32x4 acc[16];
#pragma unroll
  for (int b = 0; b < 16; ++b) acc[b] = (f32x4){0.f, 0.f, 0.f, 0.f};
  const float* wp = W + (size_t)k0 * N + lc;
#pragma unroll 4
  for (int kk = 0; kk < 128; ++kk) {
    f32x4 w = __builtin_nontemporal_load((const f32x4*)(wp + (size_t)kk * N));
#pragma unroll
    for (int q = 0; q < 4; ++q) {
      f32x4 cv = *(const f32x4*)(cact + kk * 16 + q * 4);
#pragma unroll
      for (int e = 0; e < 4; ++e) acc[q * 4 + e] += cv[e] * w;
    }
  }
#pragma unroll
  for (int b = 0; b < 16; ++b) *(f32x4*)(part + (size_t)(ks * 16 + b) * MODW + c) = acc[b];
  __syncthreads();
}

DI void phase0(const Params& p) {
  constexpr int NMOD = 14 * KSPLIT;
  constexpr int NCONV = 8192 + 2048 + 2080 + 4096 + 2048;
  for (int u = bid_opq(); u < NMOD + NCONV; u += gridDim.x) {
    if (u < NMOD) { mod_task(p, u); continue; }
    int t = u - NMOD;
    const float* W; u16* Wt; int N, ntn;
    if (t < 8192) { int l = t >> 12; t &= 4095; W = p.a_w_in + (size_t)l * 2048 * 8192; Wt = (u16*)(p.ws + WS_WT_AIN) + (size_t)l * 8192 * 2048; N = 8192; ntn = 128; }
    else if (t < 8192 + 2048) { t -= 8192; int l = t >> 10; t &= 1023; W = p.a_w_out + (size_t)l * 2048 * 2048; Wt = (u16*)(p.ws + WS_WT_AOUT) + (size_t)l * 2048 * 2048; N = 2048; ntn = 32; }
    else if (t < 8192 + 2048 + 2080) { t -= 8192 + 2048; W = p.kv_w; Wt = (u16*)(p.ws + WS_WT_KV); N = 4112; ntn = 65; }
    else if (t < 8192 + 2048 + 2080 + 4096) { t -= 8192 + 2048 + 2080; int l = t >> 11; t &= 2047; W = p.b_w_in + (size_t)l * 2048 * 4096; Wt = (u16*)(p.ws + WS_WT_BIN) + (size_t)l * 4096 * 2048; N = 4096; ntn = 64; }
    else { t -= 8192 + 2048 + 2080 + 4096; int l = t >> 10; t &= 1023; W = p.b_w_out + (size_t)l * 2048 * 2048; Wt = (u16*)(p.ws + WS_WT_BOUT) + (size_t)l * 2048 * 2048; N = 2048; ntn = 32; }
    convert_tile(W, N, Wt, t / ntn, t % ntn);
  }
}

DI void phase_modfin(const Params& p) {
  const float* part = (const float*)(p.ws + WS_PART);
  float* modf = (float*)(p.ws + WS_MODF);
  for (int idx = bid_opq() * 512 + tid_opq(); idx < 16 * (MODW / 4); idx += gridDim.x * 512) {
    int b = idx / (MODW / 4), c = (idx % (MODW / 4)) * 4;
    f32x4 s = (c < 24576) ? *(const f32x4*)(p.b_mod + c) : *(const f32x4*)(p.kv_b_mod + (c - 24576));
#pragma unroll
    for (int ks = 0; ks < KSPLIT; ++ks) s += *(const f32x4*)(part + (size_t)(ks * 16 + b) * MODW + c);
    *(f32x4*)(modf + (size_t)b * MODW + c) = s;
  }
}

DI void phase_modulate0(const Params& p) {
  const float* modf = (const float*)(p.ws + WS_MODF);
  u16* hb = (u16*)(p.ws + WS_H);
  const int tid_ = tid_opq(), lane = tid_ & 63, wave = tid_ >> 6;
  for (int row = bid_opq() * 8 + wave; row < M; row += gridDim.x * 8) {
    const int b = row >> 11;
#pragma unroll
    for (int i = 0; i < 8; ++i) {
      int col = (i * 64 + lane) * 4;
      f32x4 v = __builtin_nontemporal_load((const f32x4*)(p.x + (size_t)row * D + col));
      f32x4 sh = *(const f32x4*)(modf + (size_t)b * MODW + col);
      f32x4 sc = *(const f32x4*)(modf + (size_t)b * MODW + 2048 + col);
      f32x4 h = v * (1.f + sc) + sh;
      u32x2 o = {pack2(h[0], h[1]), pack2(h[2], h[3])};
      *(u32x2*)(hb + (size_t)row * D + col) = o;
    }
  }
}

DI void phase_ln(float* xio, const float* __restrict__ lng, const float* __restrict__ lnb,
                 const float* modn, u16* hout, const float* modkv, u16* hkout) {
  const int tid_ = tid_opq(), lane = tid_ & 63, wave = tid_ >> 6;
  for (int row0 = (bid_opq() * 8 + wave) * 2; row0 < M; row0 += gridDim.x * 16) {
    const int b = row0 >> 11;
    f32x4 v[2][8];
    float s[2] = {0.f, 0.f};
#pragma unroll
    for (int rr = 0; rr < 2; ++rr)
#pragma unroll
      for (int i = 0; i < 8; ++i) v[rr][i] = *(const f32x4*)(xio + (size_t)(row0 + rr) * D + (i * 64 + lane) * 4);
#pragma unroll
    for (int rr = 0; rr < 2; ++rr)
#pragma unroll
      for (int i = 0; i < 8; ++i) s[rr] += v[rr][i][0] + v[rr][i][1] + v[rr][i][2] + v[rr][i][3];
    float mu[2], rstd[2];
#pragma unroll
    for (int rr = 0; rr < 2; ++rr) {
      mu[rr] = wave_sum(s[rr]) * (1.f / 2048.f);
      float q = 0.f;
#pragma unroll
      for (int i = 0; i < 8; ++i) { f32x4 d = v[rr][i] - mu[rr]; q += d[0] * d[0] + d[1] * d[1] + d[2] * d[2] + d[3] * d[3]; }
      rstd[rr] = rsqrtf(wave_sum(q) * (1.f / 2048.f) + EPS);
    }
#pragma unroll
    for (int i = 0; i < 8; ++i) {
      const int col = (i * 64 + lane) * 4;
      const f32x4 g = *(const f32x4*)(lng + col), bb = *(const f32x4*)(lnb + col);
      f32x4 sh = {0.f, 0.f, 0.f, 0.f}, sc = sh, shk = sh, sck = sh;
      if (modn) { sh = *(const f32x4*)(modn + (size_t)b * MODW + col); sc = *(const f32x4*)(modn + (size_t)b * MODW + 2048 + col); }
      if (modkv) { shk = *(const f32x4*)(modkv + (size_t)b * MODW + col); sck = *(const f32x4*)(modkv + (size_t)b * MODW + 2048 + col); }
#pragma unroll
      for (int rr = 0; rr < 2; ++rr) {
        const size_t off = (size_t)(row0 + rr) * D + col;
        f32x4 y = (v[rr][i] - mu[rr]) * rstd[rr] * g + bb;
        *(f32x4*)(xio + off) = y;
        if (modn) { f32x4 h = y * (1.f + sc) + sh; u32x2 o = {pack2(h[0], h[1]), pack2(h[2], h[3])}; *(u32x2*)(hout + off) = o; }
        if (modkv) { f32x4 h = y * (1.f + sck) + shk; u32x2 o = {pack2(h[0], h[1]), pack2(h[2], h[3])}; *(u32x2*)(hkout + off) = o; }
      }
    }
  }
}

DI void phase_fscan(const Params& p) {
  const float* zf = (const float*)(p.ws + WS_ZF);
  float* F = (float*)(p.ws + WS_FCUM);
  const int tid_ = tid_opq(), lane = tid_ & 63, wave = tid_ >> 6;
  for (int seq = bid_opq() * 8 + wave; seq < 256; seq += gridDim.x * 8) {
    const int b = seq >> 4, h = seq & 15;
    const float bf = p.kv_b_f[h];
    float run = 0.f, loc[32];
#pragma unroll
    for (int j = 0; j < 32; ++j) {
      float y = zf[((size_t)b * S + lane * 32 + j) * 16 + h] + bf;
      float ls = fminf(y, 0.f) - log1pf(__expf(-fabsf(y)));
      run += ls; loc[j] = run;
    }
    float incl = run;
#pragma unroll
    for (int o = 1; o < 64; o <<= 1) { float t = __shfl_up(incl, o); if (lane >= o) incl += t; }
    const float excl = incl - run;
    float* dst = F + (size_t)seq * S + lane * 32;
#pragma unroll
    for (int j = 0; j < 32; j += 4) { f32x4 o = {loc[j] + excl, loc[j + 1] + excl, loc[j + 2] + excl, loc[j + 3] + excl}; *(f32x4*)(dst + j) = o; }
  }
}

template <int KS> DI int lds_byte(int r, int c) {
  int st = (r >> 4) * KS + (c >> 5), ob = (r & 15) * 64 + (c & 31) * 2;
  return st * 1024 + (ob ^ (((ob >> 9) & 1) << 5));
}
template <int KS> DI void stage_rc(int b, int& R, int& C) {
  int st = b >> 10, sb = b & 1023, swz = sb ^ (((sb >> 9) & 1) << 5);
  R = (st / KS) * 16 + swz / 64;
  C = (st % KS) * 32 + (swz % 64) / 2;
}
#define WAIT_V(n) asm volatile("s_waitcnt vmcnt(%0)" ::"n"(n) : "memory")

struct EpiStore { u16* out; int ld; int ncut; float* zf; };
struct EpiResid { const float* xin; float* out; const float* gate;
                  const float* lng; const float* lnb; const float* modn; u16* hout; const float* modkv; u16* hkout;
                  float* stats; unsigned* cnt; unsigned target; };

DI void epi_store(const EpiStore& E, int row, int col, f32x4 v) {
  if (col < E.ncut) { u32x2 o = {pack2(v[0], v[1]), pack2(v[2], v[3])}; *(u32x2*)(E.out + (size_t)row * E.ld + col) = o; }
  else if (col < E.ncut + 16) { *(f32x4*)(E.zf + (size_t)row * 16 + (col - E.ncut)) = v; }
}
DI void gemm_epilogue(const EpiStore& E, f32x4 (&acc)[8][4], int brow, int bcol, int, int, int, int, int) {
  const int tid = tid_opq(), wid = tid >> 6, lane = tid & 63, wr = wid >> 2, wc = wid & 3, fr = lane & 15, fq = lane >> 4;
  if (bcol + 256 > E.ncut) {
#pragma unroll
    for (int m = 0; m < 8; ++m)
#pragma unroll
      for (int n = 0; n < 4; ++n) epi_store(E, brow + wr * 128 + m * 16 + fr, bcol + wc * 64 + n * 16 + fq * 4, acc[m][n]);
  } else {
    constexpr int EP = 528;
    LAS char* eb = (LAS char*)shm + 65536;
    LAS char* wp = eb + (wr * 64 + fr) * EP + (wc * 64 + fq * 4) * 2;
    LAS char* rp = eb + (tid >> 5) * EP + (tid & 31) * 16;
    u16* gp = E.out + (size_t)(brow + (tid >> 5)) * E.ld + bcol + (tid & 31) * 8;
    __syncthreads();
#pragma unroll
    for (int half = 0; half < 2; ++half) {
#pragma unroll
      for (int mm = 0; mm < 4; ++mm)
#pragma unroll
        for (int n = 0; n < 4; ++n) {
          const f32x4 v = acc[half * 4 + mm][n];
          u32x2 o = {pack2(v[0], v[1]), pack2(v[2], v[3])};
          *(LAS u32x2*)(wp + mm * 16 * EP + n * 32) = o;
        }
      __syncthreads();
#pragma unroll
      for (int i = 0; i < 8; ++i) {
        const u32x4 v = *(LAS u32x4*)(rp + i * 16 * EP);
        __builtin_nontemporal_store(v, (u32x4*)(gp + (size_t)((i >> 2) * 128 + (i & 3) * 16 + half * 64) * E.ld));

      }
      __syncthreads();
    }
  }
}

DI void gemm_epilogue(const EpiResid& E, f32x4 (&acc)[8][4], int brow, int bcol, int, int, int, int, int) {
  const int tid = tid_opq(), wid = tid >> 6, lane = tid & 63, wr = wid >> 2, wc = wid & 3, fr = lane & 15, fq = lane >> 4;
  LAS float* st_lds = (LAS float*)((LAS char*)shm + 131072);
  LAS float* mr_lds = (LAS float*)((LAS char*)shm + 131072 + 8192);
  const int b = brow >> 11, pm = brow >> 8, pn = bcol >> 8;
  const int col0 = bcol + wc * 64 + fq * 4;
  const float* gtp = E.gate + (size_t)b * MODW + col0;
  f32x4 xa[4], xb[4];
#pragma unroll
  for (int n = 0; n < 4; ++n) xa[n] = __builtin_nontemporal_load((const f32x4*)(E.xin + (size_t)(brow + wr * 128 + fr) * D + col0 + n * 16));
#pragma unroll
  for (int m = 0; m < 8; ++m) {
    asm volatile("" ::: "memory");
    if (m + 1 < 8) {
#pragma unroll
      for (int n = 0; n < 4; ++n) {
        const f32x4 t = __builtin_nontemporal_load((const f32x4*)(E.xin + (size_t)(brow + wr * 128 + (m + 1) * 16 + fr) * D + col0 + n * 16));
        if (m & 1) xa[n] = t; else xb[n] = t;
      }
    }
    asm volatile("" ::: "memory");
    float s1 = 0.f, s2 = 0.f;
#pragma unroll
    for (int n = 0; n < 4; ++n) {
      const f32x4 gtv = *(const f32x4*)(gtp + n * 16);
      f32x4 v = DN_ALPHA * ((m & 1) ? xb[n] : xa[n]) + gtv * acc[m][n];
      acc[m][n] = v;
      s1 += (v[0] + v[1]) + (v[2] + v[3]);
      s2 = __builtin_fmaf(v[0], v[0], s2); s2 = __builtin_fmaf(v[1], v[1], s2); s2 = __builtin_fmaf(v[2], v[2], s2); s2 = __builtin_fmaf(v[3], v[3], s2);
    }
    s1 += __shfl_xor(s1, 16); s2 += __shfl_xor(s2, 16);
    s1 += __shfl_xor(s1, 32); s2 += __shfl_xor(s2, 32);
    if (fq == 0) { const int lr = wr * 128 + m * 16 + fr; st_lds[(wc * 256 + lr) * 2] = s1; st_lds[(wc * 256 + lr) * 2 + 1] = s2; }
  }
  __syncthreads();
  if (tid < 256) {
    float s1 = 0.f, s2 = 0.f;
#pragma unroll
    for (int w = 0; w < 4; ++w) { s1 += st_lds[(w * 256 + tid) * 2]; s2 += st_lds[(w * 256 + tid) * 2 + 1]; }
    float* dst = E.stats + ((size_t)(pm * 8 + pn) * 256 + tid) * 2;
    __hip_atomic_store(dst, s1, __ATOMIC_RELAXED, __HIP_MEMORY_SCOPE_AGENT);
    __hip_atomic_store(dst + 1, s2, __ATOMIC_RELAXED, __HIP_MEMORY_SCOPE_AGENT);
  }
  asm volatile("s_waitcnt vmcnt(0) lgkmcnt(0)" ::: "memory");
  __syncthreads();
  if (tid == 0) {
    __hip_atomic_fetch_add(E.cnt + pm, 1u, __ATOMIC_RELAXED, __HIP_MEMORY_SCOPE_AGENT);
    unsigned spins = 0;
    while (__hip_atomic_load(E.cnt + pm, __ATOMIC_RELAXED, __HIP_MEMORY_SCOPE_AGENT) < E.target && ++spins < (1u << 24)) __builtin_amdgcn_s_sleep(1);
  }
  __syncthreads();
  if (tid < 256) {
    float s1 = 0.f, s2 = 0.f;
#pragma unroll
    for (int j = 0; j < 8; ++j) {
      const float* src = E.stats + ((size_t)(pm * 8 + j) * 256 + tid) * 2;
      s1 += __hip_atomic_load(src, __ATOMIC_RELAXED, __HIP_MEMORY_SCOPE_AGENT); s2 += __hip_atomic_load(src + 1, __ATOMIC_RELAXED, __HIP_MEMORY_SCOPE_AGENT);
    }
    const float mu = s1 * (1.f / 2048.f);
    const float var = fmaxf(s2 * (1.f / 2048.f) - mu * mu, 0.f);
    mr_lds[tid * 2] = mu; mr_lds[tid * 2 + 1] = rsqrtf(var + EPS);
  }
  __syncthreads();
#pragma unroll
  for (int n = 0; n < 4; ++n) {
    asm volatile("" ::: "memory");
    const int col = col0 + n * 16;
    const f32x4 g = *(const f32x4*)(E.lng + col), bb = *(const f32x4*)(E.lnb + col);
    f32x4 sh = {0.f, 0.f, 0.f, 0.f}, sc = sh, shk = sh, sck = sh;
    if (E.modn) { sh = *(const f32x4*)(E.modn + (size_t)b * MODW + col); sc = *(const f32x4*)(E.modn + (size_t)b * MODW + 2048 + col); }
    if (E.modkv) { shk = *(const f32x4*)(E.modkv + (size_t)b * MODW + col); sck = *(const f32x4*)(E.modkv + (size_t)b * MODW + 2048 + col); }
#pragma unroll
    for (int m = 0; m < 8; ++m) {
      const int lr = wr * 128 + m * 16 + fr;
      const float mu = mr_lds[lr * 2], rstd = mr_lds[lr * 2 + 1];
      const size_t off = (size_t)(brow + lr) * D + col;
      f32x4 y = (acc[m][n] - mu) * rstd * g + bb;
      __builtin_nontemporal_store(y, (f32x4*)(E.out + off));
      if (E.modn) { f32x4 hh = y * (1.f + sc) + sh; u32x2 o = {pack2(hh[0], hh[1]), pack2(hh[2], hh[3])}; *(u32x2*)(E.hout + off) = o; }
      if (E.modkv) { f32x4 hh = y * (1.f + sck) + shk; u32x2 o = {pack2(hh[0], hh[1]), pack2(hh[2], hh[3])}; *(u32x2*)(E.hkout + off) = o; }
    }
  }
}

DI void tile_coords(int t, int nN, int& pm, int& pn) {
  if (nN == 17) { if (t >= 2048) { pm = t - 2048; pn = 16; return; } nN = 16; }
  const int q = t >> 8, w = t & 255, x = w & 7, i = w >> 3;
  if (nN >= 16) { const int npn = nN >> 4; pm = (q / npn) * 16 + (x & 1) * 8 + (i & 7); pn = (q % npn) * 16 + (x >> 1) * 4 + (i >> 3); }
  else { pm = q * 32 + (x & 3) * 8 + (i & 7); pn = (x >> 2) * 4 + (i >> 3); }
}

template <class Epi>
DI void gemm_phase(const u16* A, const u16* Bt, int N, const Epi& E) {
  constexpr int K = 2048, BK = 64, KS = 2, TILE_B = 256 * BK * 2, GL = 4, STAGE_B = 2 * TILE_B, NT = K / BK;
  const int tid = tid_opq(), wid = tid >> 6, lane = tid & 63, wr = wid >> 2, wc = wid & 3, fr = lane & 15, fq = lane >> 4;
  unsigned soff[GL];
#pragma unroll
  for (int i = 0; i < GL; ++i) { int sR, sC; stage_rc<KS>(wid * 1024 + i * 8192 + lane * 16, sR, sC); soff[i] = (unsigned)((sR * K + sC) * 2); }
  const int nN = N >> 8, ntiles = 128 * nN;
#define SA(b) (shm + (b) * STAGE_B)
#define SB(b) (shm + (b) * STAGE_B + TILE_B)
#define GSRC(base, i, kt) ((const char*)((base) + (kt) * BK) + soff[i])
#define GLDS_STAGE(buf, kt, Ab_, Bb_) do { _Pragma("unroll") for (int i = 0; i < GL; ++i) { \
      __builtin_amdgcn_global_load_lds((const unsigned*)GSRC(Ab_, i, kt), (unsigned*)(SA(buf) + wid * 1024 + i * 8192), 16, 0, 0); \
      __builtin_amdgcn_global_load_lds((const unsigned*)GSRC(Bb_, i, kt), (unsigned*)(SB(buf) + wid * 1024 + i * 8192), 16, 0, 0); } } while (0)
  int t = bid_opq();
  if (t >= ntiles) return;
  int pm, pn;
  tile_coords(t, nN, pm, pn);
  const u16* Ab = A + (size_t)pm * 256 * K;
  const u16* Bb = Bt + (size_t)pn * 256 * K;
  GLDS_STAGE(0, 0, Ab, Bb); WAIT_V(0); __syncthreads();
  while (true) {
    const int brow = pm * 256, bcol = pn * 256;
    const int tn = t + gridDim.x;
    const u16* Abn = Ab; const u16* Bbn = Bb;
    if (tn < ntiles) { tile_coords(tn, nN, pm, pn); Abn = A + (size_t)pm * 256 * K; Bbn = Bt + (size_t)pn * 256 * K; }
    f32x4 acc[8][4];
#pragma unroll
    for (int m = 0; m < 8; ++m)
#pragma unroll
      for (int n = 0; n < 4; ++n) acc[m][n] = (f32x4){0.f, 0.f, 0.f, 0.f};
    for (int kt = 0; kt < NT; ++kt) {
      const int cur = kt & 1;
      if (kt + 1 < NT) GLDS_STAGE(cur ^ 1, kt + 1, Ab, Bb);
      else if (tn < ntiles) GLDS_STAGE(0, 0, Abn, Bbn);
#pragma unroll
      for (int ks = 0; ks < KS; ++ks) {
        bf16x8 At[8], Bf[4];
#pragma unroll
        for (int n = 0; n < 4; ++n) Bf[n] = *(const bf16x8*)(SB(cur) + lds_byte<KS>(wc * 64 + n * 16 + fr, ks * 32 + fq * 8));
#pragma unroll
        for (int m = 0; m < 8; ++m) At[m] = *(const bf16x8*)(SA(cur) + lds_byte<KS>(wr * 128 + m * 16 + fr, ks * 32 + fq * 8));
#pragma unroll
        for (int m = 0; m < 8; ++m)
#pragma unroll
          for (int n = 0; n < 4; ++n) acc[m][n] = __builtin_amdgcn_mfma_f32_16x16x32_bf16(Bf[n], At[m], acc[m][n], 0, 0, 0);
      }
      __builtin_amdgcn_sched_group_barrier(0x100, 8, 3);
#define SGB_M4R(nr) __builtin_amdgcn_sched_group_barrier(0x008, 4, 3); __builtin_amdgcn_sched_group_barrier(0x100, nr, 3);
      SGB_M4R(1) SGB_M4R(1) SGB_M4R(1) SGB_M4R(1) SGB_M4R(3) SGB_M4R(3)
      SGB_M4R(1) SGB_M4R(1) SGB_M4R(1) SGB_M4R(1) SGB_M4R(1) SGB_M4R(1)
      __builtin_amdgcn_sched_group_barrier(0x008, 16, 3);
#undef SGB_M4R
      __builtin_amdgcn_sched_barrier(0);
      if (kt + 1 < NT) { WAIT_V(0); __syncthreads(); }
    }
    gemm_epilogue(E, acc, brow, bcol, wr, wc, fr, fq, tid);
    WAIT_V(0); __syncthreads();
    if (tn >= ntiles) break;
    t = tn; Ab = Abn; Bb = Bbn;
  }
#undef SA
#undef SB
#undef GSRC
#undef GLDS_STAGE
}

template <bool DIFF, int NKB, int NDV, int KT, int KP, int VP>
DI void attn_tile(LAS char* sm, LAS char* Ks, LAS char* Vs, LAS char* cbs, int qoff, const bf16x8 (&qf_in)[8], f32x16 (&oacc)[NDV], float& mrow, float& lrow,
                  int k0, int t0, int tq0, int lane, int r, int h, int g, int qs, float scale2, float slope2) {
  bf16x8 qf[8];
#pragma unroll
  for (int ks = 0; ks < 8; ++ks) qf[ks] = qf_in[ks];
  f32x16 sacc[NKB];
#pragma unroll
  for (int kb = 0; kb < NKB; ++kb)
#pragma unroll
    for (int i = 0; i < 16; ++i) sacc[kb][i] = 0.f;
#pragma unroll
  for (int ks = 0; ks < 8; ++ks)
#pragma unroll
    for (int kb = 0; kb < NKB; ++kb) {
      bf16x8 a = *(LAS bf16x8*)(Ks + (kb * 32 + r) * KP + (g * 128 + ks * 16 + 8 * h) * 2);
      if (DIFF) qf[ks] = *(LAS bf16x8*)(sm + qoff + (qs * 32 + r) * KP + (g * 128 + ks * 16 + 8 * h) * 2);
      sacc[kb] = __builtin_amdgcn_mfma_f32_32x32x16_bf16(a, qf[ks], sacc[kb], 0, 0, 0);
    }
  {
    constexpr int RPM = DIFF ? 2 : 1, NM = 8 * NKB;
    __builtin_amdgcn_sched_group_barrier(0x100, 2 * RPM, 0);
#pragma unroll
    for (int jq = 0; jq < NM - 2; ++jq) { __builtin_amdgcn_sched_group_barrier(0x008, 1, 0); __builtin_amdgcn_sched_group_barrier(0x100, RPM, 0); }
    __builtin_amdgcn_sched_group_barrier(0x008, 2, 0);
  }
  float mx = -1e30f;
  const int dk = k0 + 4 * h - (tq0 + r);
  const float bias0 = DIFF ? slope2 * (float)(k0 + 4 * h - t0) : 0.f;
  if (k0 + KT - 1 > tq0) {
    asm volatile("" ::: "memory");
#pragma unroll
    for (int kb = 0; kb < NKB; ++kb)
#pragma unroll
      for (int a = 0; a < 4; ++a) {
        f32x4 cb4 = {0.f, 0.f, 0.f, 0.f};
        if (!DIFF) cb4 = *(LAS f32x4*)(cbs + (g * KT + kb * 32 + 8 * a + 4 * h) * 4);
#pragma unroll
        for (int jj = 0; jj < 4; ++jj) {
          const int off = kb * 32 + 8 * a + jj;
          float sv = __builtin_fmaf(sacc[kb][4 * a + jj], scale2, DIFF ? __builtin_fmaf((float)off, slope2, bias0) : cb4[jj]);
          if (dk + off > 0) sv = -1e30f;
          sacc[kb][4 * a + jj] = sv; mx = fmaxf(mx, sv);
        }
      }
  } else {
    asm volatile("" ::: "memory");
#pragma unroll
    for (int kb = 0; kb < NKB; ++kb)
#pragma unroll
      for (int a = 0; a < 4; ++a) {
        f32x4 cb4 = {0.f, 0.f, 0.f, 0.f};
        if (!DIFF) cb4 = *(LAS f32x4*)(cbs + (g * KT + kb * 32 + 8 * a + 4 * h) * 4);
#pragma unroll
        for (int jj = 0; jj < 4; ++jj) {
          const int off = kb * 32 + 8 * a + jj;
          float sv = __builtin_fmaf(sacc[kb][4 * a + jj], scale2, DIFF ? __builtin_fmaf((float)off, slope2, bias0) : cb4[jj]);
          sacc[kb][4 * a + jj] = sv; mx = fmaxf(mx, sv);
        }
      }
  }
  mx = xor32_max(mx);
  const float mnew = fmaxf(mrow, mx);
  const float alpha = __builtin_amdgcn_exp2f(mrow - mnew);
  mrow = mnew;
  float ps = 0.f;
#pragma unroll
  for (int kb = 0; kb < NKB; ++kb)
#pragma unroll
    for (int i = 0; i < 16; ++i) { float pv = __builtin_amdgcn_exp2f(sacc[kb][i] - mnew); sacc[kb][i] = pv; ps += pv; }
  lrow = lrow * alpha + ps;
  if (__any(alpha != 1.f)) {
#pragma unroll
    for (int d = 0; d < NDV; ++d)
#pragma unroll
      for (int i = 0; i < 16; ++i) oacc[d][i] *= alpha;
  }
  bf16x8 pf[NKB][2];
#pragma unroll
  for (int kb = 0; kb < NKB; ++kb)
#pragma unroll
    for (int s2 = 0; s2 < 2; ++s2) {
      u32x4 pk = {pack2(sacc[kb][8 * s2 + 0], sacc[kb][8 * s2 + 1]), pack2(sacc[kb][8 * s2 + 2], sacc[kb][8 * s2 + 3]),
                  pack2(sacc[kb][8 * s2 + 4], sacc[kb][8 * s2 + 5]), pack2(sacc[kb][8 * s2 + 6], sacc[kb][8 * s2 + 7])};
      pf[kb][s2] = __builtin_bit_cast(bf16x8, pk);
    }
  const int vrow = 4 * h + ((lane & 15) >> 2);
  const int vcol = (DIFF ? 0 : g * 128) + 16 * ((lane >> 4) & 1) + 4 * (lane & 3);
#pragma unroll
  for (int d = 0; d < NDV; ++d)
#pragma unroll
    for (int kb = 0; kb < NKB; ++kb)
#pragma unroll
      for (int s2 = 0; s2 < 2; ++s2) {
        LAS char* vp = Vs + (kb * 32 + 16 * s2 + vrow) * VP + (vcol + d * 32) * 2;
        s16x4 lo = __builtin_amdgcn_ds_read_tr16_b64_v4i16((LAS s16x4*)vp);
        s16x4 hi = __builtin_amdgcn_ds_read_tr16_b64_v4i16((LAS s16x4*)(vp + 8 * VP));
        bf16x8 a = __builtin_shufflevector(lo, hi, 0, 1, 2, 3, 4, 5, 6, 7);
        oacc[d] = __builtin_amdgcn_mfma_f32_32x32x16_bf16(a, pf[kb][s2], oacc[d], 0, 0, 0);
      }
  {
    constexpr int NM = NDV * NKB * 2;
    __builtin_amdgcn_sched_group_barrier(0x100, 4, 1);
#pragma unroll
    for (int jq = 0; jq < NM - 2; ++jq) { __builtin_amdgcn_sched_group_barrier(0x008, 1, 1); __builtin_amdgcn_sched_group_barrier(0x100, 2, 1); }
    __builtin_amdgcn_sched_group_barrier(0x008, 2, 1);
  }
}

template <bool DIFF>
DI void attn_phase(const u16* Qb, int ldq, const u16* Kb, int ldk, const u16* Vb, int ldv, const u16* Gb, int ldg,
                   u16* Ob, const float* Fcum, float lam, float outscale, const float* subln) {
  constexpr int KT = DIFF ? 32 : 64, NKB = KT / 32, NDV = DIFF ? 8 : 4;
  constexpr int KP = 528, VP = 576, STAGE = KT * (KP + VP), NLD = KT * 32 / 512, CB_OFF = 2 * STAGE, QOFF = 2 * STAGE;
  const float scale2 = 0.08838834764831845f * LOG2E;
  LAS char* sm = (LAS char*)shm;

  for (int j = bid_opq(); j < 2048; j += gridDim.x) {
    const int tid = tid_opq(), lane = tid & 63, wave = __builtin_amdgcn_readfirstlane(tid >> 6);
    const int r = lane & 31, h = lane >> 5, g = wave >> 2, qs = wave & 3;
    const int bid = j & 255, rr = j >> 8, hp = bid & 7, ii = bid >> 3;
    const int b = 2 * rr + (ii >> 4), qb = (rr & 1) ? 15 - (ii & 15) : (ii & 15);
    const int t0 = qb * 128, tq0 = t0 + qs * 32, ntile = (t0 + 128) / KT;
    const size_t rowbase = (size_t)b * S;

    bf16x8 qf[8];
    if (DIFF) {
#pragma unroll
      for (int i = 0; i < 8; ++i) {
        const int idx = tid + i * 512, row = idx >> 5, ch = idx & 31;
        *(LAS i32x4*)(sm + QOFF + row * KP + ch * 16) = *(const i32x4*)(Qb + (rowbase + t0 + row) * ldq + hp * 256 + ch * 8);
      }
#pragma unroll
      for (int ks = 0; ks < 8; ++ks) qf[ks] = (bf16x8){0, 0, 0, 0, 0, 0, 0, 0};
    } else {
      const u16* qp = Qb + (rowbase + tq0 + r) * ldq + hp * 256 + g * 128 + 8 * h;
#pragma unroll
      for (int ks = 0; ks < 8; ++ks) qf[ks] = *(const bf16x8*)(qp + ks * 16);
    }
    f32x16 oacc[NDV];
#pragma unroll
    for (int d = 0; d < NDV; ++d)
#pragma unroll
      for (int i = 0; i < 16; ++i) oacc[d][i] = 0.f;
    float mrow = -1e30f, lrow = 0.f;
    const float slope2 = DIFF ? exp2f(-(float)(hp + 1)) * LOG2E : 0.f;
    const float* Fp = nullptr; float Ft0 = 0.f;
    if (!DIFF && tid < 2 * KT) { Fp = Fcum + ((size_t)(b * 16 + 2 * hp + tid / KT)) * S; Ft0 = Fp[t0]; }

    const unsigned koff = (unsigned)(((tid >> 5) * ldk + (tid & 31) * 8) * 2), voff = (unsigned)(((tid >> 5) * ldv + (tid & 31) * 8) * 2);
#define AT_ISSUE(KR, VR, CR, kt) do { const int k0_ = (kt) * KT; \
      const char* kbase_ = (const char*)(Kb + (rowbase + k0_) * ldk + hp * 256); \
      const char* vbase_ = (const char*)(Vb + (rowbase + k0_) * ldv + hp * 256); \
      _Pragma("unroll") for (int i = 0; i < NLD; ++i) { \
      KR[i] = *(const i32x4*)(kbase_ + (size_t)i * 16 * ldk * 2 + koff); \
      VR[i] = *(const i32x4*)(vbase_ + (size_t)i * 16 * ldv * 2 + voff); } \
      if (!DIFF && tid < 2 * KT) CR = (Ft0 - Fp[k0_ + (tid % KT)]) * LOG2E; } while (0)
#define AT_WRITE(KR, VR, CR, st) do { _Pragma("unroll") for (int i = 0; i < NLD; ++i) { \
      const int idx = tid + i * 512, row = idx >> 5, ch = idx & 31; \
      *(LAS i32x4*)(sm + (st) * STAGE + row * KP + ch * 16) = KR[i]; \
      *(LAS i32x4*)(sm + (st) * STAGE + KT * KP + row * VP + ch * 16) = VR[i]; } \
      if (!DIFF && tid < 2 * KT) *(LAS float*)(sm + CB_OFF + ((st) * 2 * KT + tid) * 4) = CR; } while (0)
#define AT_COMPUTE(it_, st) do { const int k0c_ = (ntile - 1 - (it_)) * KT; if (k0c_ <= tq0 + 31) \
      attn_tile<DIFF, NKB, NDV, KT, KP, VP>(sm, sm + (st) * STAGE, sm + (st) * STAGE + KT * KP, sm + CB_OFF + (st) * 2 * KT * 4, QOFF, qf, oacc, mrow, lrow, \
                                             k0c_, t0, tq0, lane, r, h, g, qs, scale2, slope2); } while (0)
    i32x4 kregA[NLD], vregA[NLD]; float cbregA = 0.f;
    {
      i32x4 kregB[NLD], vregB[NLD]; float cbregB = 0.f;
      AT_ISSUE(kregA, vregA, cbregA, ntile - 1); AT_WRITE(kregA, vregA, cbregA, 0);
      AT_ISSUE(kregA, vregA, cbregA, max(ntile - 2, 0));
      AT_ISSUE(kregB, vregB, cbregB, max(ntile - 3, 0));
      __syncthreads();
      for (int it = 0; it < ntile; it += 2) {
        AT_COMPUTE(it, 0);
        AT_WRITE(kregA, vregA, cbregA, 1);
        AT_ISSUE(kregA, vregA, cbregA, max(ntile - 4 - it, 0));
        __syncthreads();
        AT_COMPUTE(it + 1, 1);
        AT_WRITE(kregB, vregB, cbregB, 0);
        AT_ISSUE(kregB, vregB, cbregB, max(ntile - 5 - it, 0));
        __syncthreads();
      }
    }
#undef AT_ISSUE
#undef AT_WRITE
#undef AT_COMPUTE
    int lo_ = lane; asm volatile("" : "+v"(lo_));
    const int h_ = lo_ >> 5, r_ = lo_ & 31;
    const float ltot = lrow + __shfl_xor(lrow, 32);
    const float inv = 1.f / ltot;
    const size_t orow = rowbase + tq0 + r_;
    const int cbase = hp * 256 + (DIFF ? 0 : g * 128) + 4 * h_;
    const u16* gptr = Gb + orow * ldg + cbase;
    u16* optr = Ob + orow * D + cbase;
    if (!DIFF) {
#pragma unroll
      for (int d = 0; d < NDV; ++d)
#pragma unroll
        for (int a = 0; a < 4; ++a) {
          u32x2 gz = *(const u32x2*)(gptr + d * 32 + 8 * a);
          float o0 = oacc[d][4 * a + 0] * inv * silu_f(bf_lo(gz[0]));
          float o1 = oacc[d][4 * a + 1] * inv * silu_f(bf_hi(gz[0]));
          float o2 = oacc[d][4 * a + 2] * inv * silu_f(bf_lo(gz[1]));
          float o3 = oacc[d][4 * a + 3] * inv * silu_f(bf_hi(gz[1]));
          u32x2 o = {pack2(o0, o1), pack2(o2, o3)};
          *(u32x2*)(optr + d * 32 + 8 * a) = o;
        }
    } else {
      constexpr int IP = 1040;
      LAS char* img = sm + (qs * 32 + r_) * IP + 16 * h_;
      LAS float* rnorm = (LAS float*)(sm + 128 * IP);
      if (g == 1) {
        const float sc = lam * inv;
#pragma unroll
        for (int d = 0; d < NDV; ++d)
#pragma unroll
          for (int a = 0; a < 4; ++a) {
            f32x4 v = {oacc[d][4 * a] * sc, oacc[d][4 * a + 1] * sc, oacc[d][4 * a + 2] * sc, oacc[d][4 * a + 3] * sc};
            *(LAS f32x4*)(img + (d * 32 + 8 * a) * 4) = v;
          }
      }
      __syncthreads();
      if (g == 0) {
        float ss = 0.f;
#pragma unroll
        for (int d = 0; d < NDV; ++d)
#pragma unroll
          for (int a = 0; a < 4; ++a) {
            LAS f32x4* pp = (LAS f32x4*)(img + (d * 32 + 8 * a) * 4);
            const f32x4 x4 = *pp;
            f32x4 dv;
#pragma unroll
            for (int jj = 0; jj < 4; ++jj) { dv[jj] = oacc[d][4 * a + jj] * inv - x4[jj]; ss = __builtin_fmaf(dv[jj], dv[jj], ss); }
            *pp = dv;
          }
        ss += __shfl_xor(ss, 32);
        if (h_ == 0) rnorm[qs * 32 + r_] = rsqrtf(ss * (1.f / 256.f) + EPS) * outscale;
      }
      __syncthreads();
      {
        int t2 = tid; asm volatile("" : "+v"(t2));
        const int c8 = t2 & 31, rg = t2 >> 5;
        const f32x4 sg0 = *(const f32x4*)(subln + c8 * 8), sg1 = *(const f32x4*)(subln + c8 * 8 + 4);
        const u16* gp2 = Gb + (rowbase + t0 + rg) * ldg + hp * 256 + c8 * 8;
        u16* op2 = Ob + (rowbase + t0 + rg) * D + hp * 256 + c8 * 8;
        LAS char* ip2 = sm + rg * IP + c8 * 32;
#pragma unroll
        for (int i = 0; i < 8; ++i) {
          const u32x4 gz = *(const u32x4*)(gp2 + (size_t)i * 16 * ldg);
          const f32x4 d0 = *(LAS f32x4*)(ip2 + i * 16 * IP), d1 = *(LAS f32x4*)(ip2 + i * 16 * IP + 16);
          const float rn = rnorm[rg + 16 * i];
          u32x4 o;
          o[0] = pack2(d0[0] * rn * sg0[0] * silu_f(bf_lo(gz[0])), d0[1] * rn * sg0[1] * silu_f(bf_hi(gz[0])));
          o[1] = pack2(d0[2] * rn * sg0[2] * silu_f(bf_lo(gz[1])), d0[3] * rn * sg0[3] * silu_f(bf_hi(gz[1])));
          o[2] = pack2(d1[0] * rn * sg1[0] * silu_f(bf_lo(gz[2])), d1[1] * rn * sg1[1] * silu_f(bf_hi(gz[2])));
          o[3] = pack2(d1[2] * rn * sg1[2] * silu_f(bf_lo(gz[3])), d1[3] * rn * sg1[3] * silu_f(bf_hi(gz[3])));
          *(u32x4*)(op2 + (size_t)i * 16 * D) = o;
        }
      }
      __syncthreads();
    }
  }
}

DI void attn_fox_phase(const u16* Qb, int ldq, const u16* Kb, int ldk, const u16* Vb, int ldv, const u16* Gb, int ldg, u16* Ob, const float* Fcum) {
  constexpr int KT = 64, NKB = 2, NDV = 4, KP = 272, VP = 320, STAGE = KT * (KP + VP), CB_OFF = 2 * STAGE, NLD = 2;
  const float scale2 = 0.08838834764831845f * LOG2E;
  LAS char* sm = (LAS char*)shm;
  for (int j = bid_opq(); j < 2048; j += gridDim.x) {
    const int tid = tid_opq(), lane = tid & 63, wave = __builtin_amdgcn_readfirstlane(tid >> 6);
    const int r = lane & 31, h = lane >> 5, qs = wave;
    const int bid = j & 255, rr = j >> 8, xx = bid & 7, ii = bid >> 3;
    const int head = xx + 8 * ((ii >> 3) & 1), b = 2 * rr + (ii >> 4), qb = (rr & 1) ? 7 - (ii & 7) : (ii & 7);
    const int t0 = qb * 256, tq0 = t0 + qs * 32, ntile = (t0 + 256) / KT;
    const size_t rowbase = (size_t)b * S;
    bf16x8 qf[8];
    {
      const u16* qp = Qb + (rowbase + tq0 + r) * ldq + head * 128 + 8 * h;
#pragma unroll
      for (int ks = 0; ks < 8; ++ks) qf[ks] = *(const bf16x8*)(qp + ks * 16);
    }
    f32x16 oacc[NDV];
#pragma unroll
    for (int d = 0; d < NDV; ++d)
#pragma unroll
      for (int i = 0; i < 16; ++i) oacc[d][i] = 0.f;
    float mrow = -1e30f, lrow = 0.f;
    const float* Fp = Fcum + ((size_t)(b * 16 + head)) * S + (tid & 63);
    const float Ft0 = Fp[t0 - (tid & 63)];
    const unsigned koff = (unsigned)(((tid >> 4) * ldk + (tid & 15) * 8) * 2), voff = (unsigned)(((tid >> 4) * ldv + (tid & 15) * 8) * 2);
#define FX_ISSUE(KR, VR, CR, kt) do { const int k0_ = (kt) * KT; \
      const char* kbase_ = (const char*)(Kb + (rowbase + k0_) * ldk + head * 128); \
      const char* vbase_ = (const char*)(Vb + (rowbase + k0_) * ldv + head * 128); \
      _Pragma("unroll") for (int i = 0; i < NLD; ++i) { \
      KR[i] = *(const i32x4*)(kbase_ + (size_t)i * 32 * ldk * 2 + koff); \
      VR[i] = *(const i32x4*)(vbase_ + (size_t)i * 32 * ldv * 2 + voff); } \
      CR = (Ft0 - Fp[k0_]) * LOG2E; } while (0)
#define FX_WRITE(KR, VR, CR, st) do { _Pragma("unroll") for (int i = 0; i < NLD; ++i) { \
      const int idx = tid + i * 512, row = idx >> 4, ch = idx & 15; \
      *(LAS i32x4*)(sm + (st) * STAGE + row * KP + ch * 16) = KR[i]; \
      *(LAS i32x4*)(sm + (st) * STAGE + KT * KP + row * VP + ch * 16) = VR[i]; } \
      if (tid < KT) *(LAS float*)(sm + CB_OFF + ((st) * KT + tid) * 4) = CR; } while (0)
#define FX_COMPUTE(it_, st) do { const int k0c_ = (ntile - 1 - (it_)) * KT; if (k0c_ <= tq0 + 31) \
      attn_tile<false, NKB, NDV, KT, KP, VP>(sm, sm + (st) * STAGE, sm + (st) * STAGE + KT * KP, sm + CB_OFF + (st) * KT * 4, 0, qf, oacc, mrow, lrow, \
                                              k0c_, t0, tq0, lane, r, h, 0, qs, scale2, 0.f); } while (0)
    i32x4 kregA[NLD], vregA[NLD], kregB[NLD], vregB[NLD]; float cbregA = 0.f, cbregB = 0.f;
    FX_ISSUE(kregA, vregA, cbregA, ntile - 1); FX_WRITE(kregA, vregA, cbregA, 0);
    FX_ISSUE(kregA, vregA, cbregA, max(ntile - 2, 0));
    FX_ISSUE(kregB, vregB, cbregB, max(ntile - 3, 0));
    __syncthreads();
    for (int it = 0; it < ntile; it += 2) {
      FX_COMPUTE(it, 0);
      FX_WRITE(kregA, vregA, cbregA, 1);
      FX_ISSUE(kregA, vregA, cbregA, max(ntile - 4 - it, 0));
      __syncthreads();
      FX_COMPUTE(it + 1, 1);
      FX_WRITE(kregB, vregB, cbregB, 0);
      FX_ISSUE(kregB, vregB, cbregB, max(ntile - 5 - it, 0));
      __syncthreads();
    }
#undef FX_ISSUE
#undef FX_WRITE
#undef FX_COMPUTE
    int lo_ = lane; asm volatile("" : "+v"(lo_));
    const int h_ = lo_ >> 5, r_ = lo_ & 31;
    const float ltot = lrow + __shfl_xor(lrow, 32);
    const float inv = 1.f / ltot;
    constexpr int IP = 528;
    {
      LAS char* img = sm + (qs * 32 + r_) * IP + 16 * h_;
#pragma unroll
      for (int d = 0; d < NDV; ++d)
#pragma unroll
        for (int a = 0; a < 4; ++a) {
          f32x4 v = {oacc[d][4 * a] * inv, oacc[d][4 * a + 1] * inv, oacc[d][4 * a + 2] * inv, oacc[d][4 * a + 3] * inv};
          *(LAS f32x4*)(img + (d * 32 + 8 * a) * 4) = v;
        }
    }
    __syncthreads();
    {
      int t2 = tid; asm volatile("" : "+v"(t2));
      const int c8 = t2 & 15, rg = t2 >> 4;
      const u16* gp2 = Gb + (rowbase + t0 + rg) * ldg + head * 128 + c8 * 8;
      u16* op2 = Ob + (rowbase + t0 + rg) * D + head * 128 + c8 * 8;
      LAS char* ip2 = sm + rg * IP + c8 * 32;
#pragma unroll
      for (int i = 0; i < 8; ++i) {
        const u32x4 gz = *(const u32x4*)(gp2 + (size_t)i * 32 * ldg);
        const f32x4 d0 = *(LAS f32x4*)(ip2 + i * 32 * IP), d1 = *(LAS f32x4*)(ip2 + i * 32 * IP + 16);
        u32x4 o;
        o[0] = pack2(d0[0] * silu_f(bf_lo(gz[0])), d0[1] * silu_f(bf_hi(gz[0])));
        o[1] = pack2(d0[2] * silu_f(bf_lo(gz[1])), d0[3] * silu_f(bf_hi(gz[1])));
        o[2] = pack2(d1[0] * silu_f(bf_lo(gz[2])), d1[1] * silu_f(bf_hi(gz[2])));
        o[3] = pack2(d1[2] * silu_f(bf_lo(gz[3])), d1[3] * silu_f(bf_hi(gz[3])));
        *(u32x4*)(op2 + (size_t)i * 32 * D) = o;
      }
    }
    __syncthreads();
  }
}

DI void grid_bar(unsigned* ctr, unsigned target) {
  asm volatile("s_waitcnt vmcnt(0) lgkmcnt(0)" ::: "memory");
  __syncthreads();
  if (threadIdx.x == 0) {
    __builtin_amdgcn_fence(__ATOMIC_RELEASE, "agent");
    asm volatile("s_waitcnt vmcnt(0)" ::: "memory");
    __hip_atomic_fetch_add(ctr, 1u, __ATOMIC_RELAXED, __HIP_MEMORY_SCOPE_AGENT);
    unsigned spins = 0;
    while (__hip_atomic_load(ctr, __ATOMIC_RELAXED, __HIP_MEMORY_SCOPE_AGENT) < target && ++spins < (1u << 24)) __builtin_amdgcn_s_sleep(2);
    __builtin_amdgcn_fence(__ATOMIC_ACQUIRE, "agent");
    asm volatile("s_waitcnt vmcnt(0)" ::: "memory");
  }
  __syncthreads();
}

__global__ void __launch_bounds__(512, 2) mk_fwd(Params p_arg) {
  cg::grid_group grid = cg::this_grid();
  typedef __attribute__((address_space(4))) const Params* KP;
  KP kp0 = (KP)__builtin_amdgcn_kernarg_segment_ptr();
  Params p;
  p.ws = kp0->ws; p.ph_lo = kp0->ph_lo; p.ph_hi = kp0->ph_hi;
  char* ws = p.ws;
  float* modf = (float*)(ws + WS_MODF);
  u16* hb = (u16*)(ws + WS_H);
  u16* proj = (u16*)(ws + WS_PROJ);
  u16* kvb = proj + (size_t)M * 4096;
  unsigned* bar = (unsigned*)(ws + WS_BAR);
  if (blockIdx.x == 0 && threadIdx.x < 256) __hip_atomic_store(bar + threadIdx.x, 0u, __ATOMIC_RELAXED, __HIP_MEMORY_SCOPE_AGENT);
  unsigned nbar = 0;
  for (int ph = p.ph_lo; ph < p.ph_hi; ++ph) {
    if (ph == p.ph_lo + 1) grid.sync();
    else if (ph > p.ph_lo + 1) { ++nbar; grid_bar(bar, nbar * gridDim.x); }
    { KP q_ = kp0; asm volatile("" : "+s"(q_)); const int lo_ = p.ph_lo, hi_ = p.ph_hi; p = *(const Params*)q_; p.ph_lo = lo_; p.ph_hi = hi_; }
    if (ph == 0) phase0(p);
    else if (ph == 1) phase_modfin(p);
    else if (ph == 2) phase_modulate0(p);
    else if (ph == 9) {
      EpiStore E{kvb, 4096, 4096, (float*)(ws + WS_ZF)};
      gemm_phase(proj  , (const u16*)(ws + WS_WT_KV), 4352, E);
    } else {
      const bool isA = ph < 9;
      const int q = isA ? ph - 3 : ph - 10, li = q / 3, sub = q % 3, l = isA ? li : 2 + li;
      if (sub == 0) {
        if (l == 2) { phase_fscan(p); }
        const u16* Bt = isA ? (const u16*)(ws + WS_WT_AIN) + (size_t)li * 8192 * 2048 : (const u16*)(ws + WS_WT_BIN) + (size_t)li * 4096 * 2048;
        const int N = isA ? 8192 : 4096;
        EpiStore E{proj, N, N, nullptr};
        gemm_phase(hb, Bt, N, E);
      } else if (sub == 1) {
        if (isA) {
          const int lane = tid_opq() & 63;
          float s1 = p.lq1[l * 128 + lane] * p.lk1[l * 128 + lane] + p.lq1[l * 128 + 64 + lane] * p.lk1[l * 128 + 64 + lane];
          float s2 = p.lq2[l * 128 + lane] * p.lk2[l * 128 + lane] + p.lq2[l * 128 + 64 + lane] * p.lk2[l * 128 + 64 + lane];
          s1 = wave_sum(s1); s2 = wave_sum(s2);
          const float lam_init = 0.8f - 0.6f * expf(-0.3f * (float)l);
          const float lam = expf(s1) - expf(s2) + lam_init;
          attn_phase<true>(proj, 8192, proj + 2048, 8192, proj + 4096, 8192, proj + 6144, 8192, hb, nullptr, lam, 1.f - lam_init, p.subln + l * 256);
        } else {
          attn_fox_phase(proj, 4096, kvb, 4096, kvb + 2048, 4096, proj + 2048, 4096, hb, (const float*)(ws + WS_FCUM));
        }
      } else {
        const u16* Bt = isA ? (const u16*)(ws + WS_WT_AOUT) + (size_t)li * 2048 * 2048 : (const u16*)(ws + WS_WT_BOUT) + (size_t)li * 2048 * 2048;
        EpiResid E{l == 0 ? p.x : p.out, p.out, modf + l * 6144 + 4096, p.ln_g + l * 2048, p.ln_b + l * 2048,
                   l < 3 ? modf + (l + 1) * 6144 : nullptr, hb, l == 1 ? modf + 24576 : nullptr, proj,
                   (float*)(ws + WS_STATS), bar + 64, 8u * (unsigned)(l + 1)};
        gemm_phase(hb, Bt, 2048, E);
      }
    }
  }
}

extern "C" void kernel_launch(void* const* d_in, const int* in_sizes, int n_in, void* d_out, int out_size, void* d_ws, size_t ws_size,
                              hipStream_t stream) {
  static int grid = 0;
  if (grid == 0) {
    if (ws_size < WS_END) { fprintf(stderr, "kernel_launch: workspace too small: %zu < %zu\n", ws_size, (size_t)WS_END); grid = -1; return; }
    int dev = 0, cus = 0, per_cu = 0;
    hipGetDevice(&dev);
    hipDeviceGetAttribute(&cus, hipDeviceAttributeMultiprocessorCount, dev);
    if (hipFuncSetAttribute((const void*)mk_fwd, hipFuncAttributeMaxDynamicSharedMemorySize, LDS_BYTES) != hipSuccess) { fprintf(stderr, "kernel_launch: hipFuncSetAttribute failed\n"); grid = -1; return; }
    if (hipOccupancyMaxActiveBlocksPerMultiprocessor(&per_cu, (const void*)mk_fwd, 512, LDS_BYTES) != hipSuccess || per_cu < 1) per_cu = 1;
    (void)hipGetLastError();
    grid = cus * per_cu;
    fprintf(stderr, "kernel_launch: cus %d per_cu %d grid %d\n", cus, per_cu, grid);
  }
  if (grid < 0) return;
  Params p{};
  p.x = (const float*)d_in[0]; p.c = (const float*)d_in[1]; p.w_mod = (const float*)d_in[2]; p.b_mod = (const float*)d_in[3];
  p.ln_g = (const float*)d_in[4]; p.ln_b = (const float*)d_in[5]; p.a_w_in = (const float*)d_in[6]; p.a_w_out = (const float*)d_in[7];
  p.lq1 = (const float*)d_in[8]; p.lk1 = (const float*)d_in[9]; p.lq2 = (const float*)d_in[10]; p.lk2 = (const float*)d_in[11];
  p.subln = (const float*)d_in[12]; p.kv_w_mod = (const float*)d_in[13]; p.kv_b_mod = (const float*)d_in[14]; p.kv_w = (const float*)d_in[15];
  p.kv_b_f = (const float*)d_in[16]; p.b_w_in = (const float*)d_in[17]; p.b_w_out = (const float*)d_in[18];
  p.out = (float*)d_out; p.ws = (char*)d_ws;
  p.ph_lo = 0; p.ph_hi = NPHASE;
  void* args[] = {&p};
  hipError_t e = hipLaunchCooperativeKernel((void*)mk_fwd, dim3(grid), dim3(512), args, LDS_BYTES, stream);
  if (e != hipSuccess) fprintf(stderr, "cooperative launch failed: %s (grid %d)\n", hipGetErrorString(e), grid);
}
```
